# Optimizing an MI355X kernel written in HIP

```python
import math
import jax, jax.numpy as jnp
from jax import lax
import numpy as np


D_MODEL = 2048
BATCH = 8
SEQ = 2048
DEPTH = 1

CHUNK = 64
Q_BLOCK = 128
N_MEM = 256
HG_HEADS = 16
HG_KDIM = 128
HG_VDIM = D_MODEL // HG_HEADS
HG_K = HG_HEADS * HG_KDIM
HG_V = HG_HEADS * HG_VDIM
MLA_HEADS = 16
Q_LORA = 512
KV_LORA = 512
QK_NOPE = 128
QK_ROPE = 64
V_HEAD = 128
MLA_QK = QK_NOPE + QK_ROPE
MLA_V = MLA_HEADS * V_HEAD
ROPE_THETA = 10000.0
XA_HEADS = 4
XA_HEAD_DIM = 128
XA_WIDTH = XA_HEADS * XA_HEAD_DIM
D_FF = 5632
FFN_RESIDUAL_WEIGHT = 0.5
EPS = 1e-6
IN_SPLITS = (HG_K, HG_K, HG_V, HG_V, Q_LORA, KV_LORA, QK_ROPE, D_MODEL, D_MODEL)
IN_DIM = HG_K + HG_K + HG_V + HG_V + Q_LORA + KV_LORA + QK_ROPE + D_MODEL + D_MODEL

kernel_name = 'hybrid_hgrn2_mla_macaron_sandwich_memory_block'


def rms_norm(x, g):
    xf = x.astype(jnp.float32)
    y = xf * lax.rsqrt(jnp.mean(xf * xf, axis=-1, keepdims=True) + EPS)
    return (y * g.astype(jnp.float32)).astype(x.dtype)


def rotary(x, cos, sin):
    x1, x2 = jnp.split(x, 2, axis=-1)
    return jnp.concatenate([x1 * cos - x2 * sin, x2 * cos + x1 * sin], axis=-1)


def split_columns(u):
    parts, start = [], 0
    for width in IN_SPLITS:
        parts.append(u[..., start:start + width])
        start += width
    return parts


def swiglu_half_step(x, pre_g, w_gate, w_up, w_down, post_g):
    h = rms_norm(x, pre_g)
    y = (jax.nn.silu(h @ w_gate) * (h @ w_up)) @ w_down
    return x + FFN_RESIDUAL_WEIGHT * rms_norm(y, post_g)


def hgrn2_chunk_scan(q, k, log_f, v):
    B, S, H, K = q.shape
    V = v.shape[-1]
    n = S // CHUNK

    def to_chunks(t):
        return t.reshape(B, n, CHUNK, H, t.shape[-1]).transpose(1, 0, 3, 2, 4)

    causal = jnp.tril(jnp.ones((CHUNK, CHUNK), dtype=bool))

    def step(state, inp):
        qc, kc, gc, vc = inp
        b = jnp.cumsum(gc, axis=2)
        diff = b[:, :, :, None, :] - b[:, :, None, :, :]
        decay = jnp.exp(jnp.where(causal[None, None, :, :, None], diff, -jnp.inf))
        scores = jnp.einsum('bhtk,bhsk,bhtsk->bhts', qc, kc, decay)
        o = (jnp.einsum('bhts,bhsv->bhtv', scores, vc)
             + jnp.einsum('bhtk,bhkv->bhtv', qc * jnp.exp(b), state))
        b_last = b[:, :, -1:, :]
        new_state = (jnp.exp(b_last[:, :, 0, :])[..., None] * state
                     + jnp.einsum('bhsk,bhsv->bhkv', kc * jnp.exp(b_last - b), vc))
        return new_state, o

    state0 = jnp.zeros((B, H, K, V), jnp.float32)
    _, o = lax.scan(step, state0, (to_chunks(q), to_chunks(k), to_chunks(log_f), to_chunks(v)))
    return o.transpose(1, 0, 3, 2, 4).reshape(B, S, H, V)


def chunk_causal_attention(q, k, v, scale):
    B, S, H, Dqk = q.shape
    Dv = v.shape[-1]
    nblk = S // Q_BLOCK
    qb = q.reshape(B, nblk, Q_BLOCK, H, Dqk).transpose(1, 0, 2, 3, 4)
    key_chunk = jnp.arange(S) // CHUNK

    def one_block(args):
        blk, q_blk = args
        query_chunk = (blk * Q_BLOCK + jnp.arange(Q_BLOCK)) // CHUNK
        mask = key_chunk[None, :] <= query_chunk[:, None]
        s = jnp.einsum('bqhd,bkhd->bhqk', q_blk, k, preferred_element_type=jnp.float32) * scale
        s = jnp.where(mask[None, None], s, -jnp.inf)
        p = jax.nn.softmax(s, axis=-1).astype(v.dtype)
        return jnp.einsum('bhqk,bkhd->bqhd', p, v)

    out = lax.map(one_block, (jnp.arange(nblk), qb))
    return out.transpose(1, 0, 2, 3, 4).reshape(B, S, H, Dv)


def hybrid_mixer(x, cos, sin, lb, pre_g, w_in, hg_norm_g, q_norm_g, w_q_up, kv_norm_g,
                 w_kv_up, w_branch_a, w_branch_b, w_out, post_g):
    B, S, _ = x.shape
    f32 = jnp.float32
    h = rms_norm(x, pre_g)
    u = h @ w_in
    q_hg, f_hg, i_hg, og_hg, c_q, c_kv, k_pe, gate_a, gate_b = split_columns(u)

    f_raw = f_hg.astype(f32).reshape(B, S, HG_HEADS, HG_KDIM)
    lb_h = lb.reshape(HG_HEADS, HG_KDIM)
    log_f = jnp.logaddexp(jnp.log(lb_h), jnp.log1p(-lb_h) + jax.nn.log_sigmoid(f_raw))
    k_in = (1.0 - lb_h) * jax.nn.sigmoid(-f_raw)
    q_in = jax.nn.silu(q_hg.astype(f32)).reshape(B, S, HG_HEADS, HG_KDIM)
    v_in = i_hg.astype(f32).reshape(B, S, HG_HEADS, HG_VDIM)
    o_a = hgrn2_chunk_scan(q_in, k_in, log_f, v_in).astype(x.dtype)
    o_a = (rms_norm(o_a, hg_norm_g.reshape(HG_HEADS, HG_VDIM))
           * jax.nn.silu(og_hg).reshape(B, S, HG_HEADS, HG_VDIM))
    y_a = o_a.reshape(B, S, HG_V) @ w_branch_a

    q = (rms_norm(c_q, q_norm_g) @ w_q_up).reshape(B, S, MLA_HEADS, MLA_QK)
    q_nope, q_pe = q[..., :QK_NOPE], q[..., QK_NOPE:]
    q_pe = rotary(q_pe, cos[:, :, None, :], sin[:, :, None, :])
    kv = (rms_norm(c_kv, kv_norm_g) @ w_kv_up).reshape(B, S, MLA_HEADS, QK_NOPE + V_HEAD)
    k_nope, v = kv[..., :QK_NOPE], kv[..., QK_NOPE:]
    k_pe = rotary(k_pe, cos, sin)
    q_full = jnp.concatenate([q_nope, q_pe], axis=-1)
    k_full = jnp.concatenate(
        [k_nope, jnp.broadcast_to(k_pe[:, :, None, :], (B, S, MLA_HEADS, QK_ROPE))], axis=-1)
    o_b = chunk_causal_attention(q_full, k_full, v, MLA_QK ** -0.5)
    y_b = o_b.reshape(B, S, MLA_V) @ w_branch_b

    y = jax.nn.sigmoid(gate_a) * y_a + jax.nn.sigmoid(gate_b) * y_b
    return x + rms_norm(y @ w_out, post_g)


def memory_cross_attention(x, mem, pre_g, mem_g, w_q, w_k, w_v, w_o, post_g):
    B, S, _ = x.shape
    M = mem.shape[1]
    h = rms_norm(x, pre_g)
    m = rms_norm(mem, mem_g)
    q = (h @ w_q).reshape(B, S, XA_HEADS, XA_HEAD_DIM)
    k = (m @ w_k).reshape(B, M, XA_HEADS, XA_HEAD_DIM)
    v = (m @ w_v).reshape(B, M, XA_HEADS, XA_HEAD_DIM)
    s = jnp.einsum('bqhd,bkhd->bhqk', q, k, preferred_element_type=jnp.float32) * XA_HEAD_DIM ** -0.5
    p = jax.nn.softmax(s, axis=-1).astype(v.dtype)
    o = jnp.einsum('bhqk,bkhd->bqhd', p, v).reshape(B, S, XA_WIDTH)
    return x + rms_norm(o @ w_o, post_g)


def setup_inputs(seed: int = 0) -> dict:
    key = jax.random.key(seed)
    ks = iter(jax.random.split(key, 40))
    L = DEPTH

    def w(shape, fan_in):
        return jax.random.normal(next(ks), shape, jnp.float32) * fan_in ** -0.5

    def gain(n):
        return 1.0 + 0.02 * jax.random.normal(next(ks), (L, n), jnp.float32)

    x = jax.random.normal(next(ks), (BATCH, SEQ, D_MODEL), jnp.float32)
    mem = jax.random.normal(next(ks), (BATCH, N_MEM, D_MODEL), jnp.float32)
    offset = jax.random.randint(next(ks), (BATCH, 1), 0, 64, dtype=jnp.int32) * CHUNK
    positions = (offset + jnp.arange(SEQ, dtype=jnp.int32)[None, :]).astype(jnp.int32)
    hgrn_lb_logits = 0.5 * jax.random.normal(next(ks), (L + 1, HG_K), jnp.float32)
    return {
        'x': x, 'mem': mem, 'positions': positions, 'hgrn_lb_logits': hgrn_lb_logits,
        'ffn1_pre_g': gain(D_MODEL),
        'ffn1_w_gate': w((L, D_MODEL, D_FF), D_MODEL),
        'ffn1_w_up': w((L, D_MODEL, D_FF), D_MODEL),
        'ffn1_w_down': w((L, D_FF, D_MODEL), D_FF),
        'ffn1_post_g': gain(D_MODEL),
        'mix_pre_g': gain(D_MODEL),
        'w_in': w((L, D_MODEL, IN_DIM), D_MODEL),
        'hg_norm_g': gain(HG_V),
        'mla_q_norm_g': gain(Q_LORA),
        'mla_w_q_up': w((L, Q_LORA, MLA_HEADS * MLA_QK), Q_LORA),
        'mla_kv_norm_g': gain(KV_LORA),
        'mla_w_kv_up': w((L, KV_LORA, MLA_HEADS * (QK_NOPE + V_HEAD)), KV_LORA),
        'w_branch_a': w((L, HG_V, D_MODEL), HG_V),
        'w_branch_b': w((L, MLA_V, D_MODEL), MLA_V),
        'w_out': w((L, D_MODEL, D_MODEL), D_MODEL),
        'mix_post_g': gain(D_MODEL),
        'xa_pre_g': gain(D_MODEL),
        'xa_mem_g': gain(D_MODEL),
        'xa_w_q': w((L, D_MODEL, XA_WIDTH), D_MODEL),
        'xa_w_k': w((L, D_MODEL, XA_WIDTH), D_MODEL),
        'xa_w_v': w((L, D_MODEL, XA_WIDTH), D_MODEL),
        'xa_w_o': w((L, XA_WIDTH, D_MODEL), XA_WIDTH),
        'xa_post_g': gain(D_MODEL),
        'ffn2_pre_g': gain(D_MODEL),
        'ffn2_w_gate': w((L, D_MODEL, D_FF), D_MODEL),
        'ffn2_w_up': w((L, D_MODEL, D_FF), D_MODEL),
        'ffn2_w_down': w((L, D_FF, D_MODEL), D_FF),
        'ffn2_post_g': gain(D_MODEL),
    }


def reference(x, mem, positions, hgrn_lb_logits,
              ffn1_pre_g, ffn1_w_gate, ffn1_w_up, ffn1_w_down, ffn1_post_g,
              mix_pre_g, w_in, hg_norm_g, mla_q_norm_g, mla_w_q_up, mla_kv_norm_g, mla_w_kv_up,
              w_branch_a, w_branch_b, w_out, mix_post_g,
              xa_pre_g, xa_mem_g, xa_w_q, xa_w_k, xa_w_v, xa_w_o, xa_post_g,
              ffn2_pre_g, ffn2_w_gate, ffn2_w_up, ffn2_w_down, ffn2_post_g):
    f32 = jnp.float32
    inv_freq = 1.0 / (ROPE_THETA ** (jnp.arange(0, QK_ROPE, 2, dtype=f32) / QK_ROPE))
    ang = positions.astype(f32)[..., None] * inv_freq
    cos = jnp.cos(ang).astype(x.dtype)
    sin = jnp.sin(ang).astype(x.dtype)
    lower_bounds = jnp.cumsum(jax.nn.softmax(hgrn_lb_logits.astype(f32), axis=0), axis=0)

    for l in range(DEPTH):
        x = swiglu_half_step(x, ffn1_pre_g[l], ffn1_w_gate[l], ffn1_w_up[l], ffn1_w_down[l], ffn1_post_g[l])
        x = hybrid_mixer(x, cos, sin, lower_bounds[l], mix_pre_g[l], w_in[l], hg_norm_g[l],
                         mla_q_norm_g[l], mla_w_q_up[l], mla_kv_norm_g[l], mla_w_kv_up[l],
                         w_branch_a[l], w_branch_b[l], w_out[l], mix_post_g[l])
        x = memory_cross_attention(x, mem, xa_pre_g[l], xa_mem_g[l], xa_w_q[l], xa_w_k[l],
                                   xa_w_v[l], xa_w_o[l], xa_post_g[l])
        x = swiglu_half_step(x, ffn2_pre_g[l], ffn2_w_gate[l], ffn2_w_up[l], ffn2_w_down[l], ffn2_post_g[l])
    return x
```

```cpp
#include <hip/hip_runtime.h>
#include <hip/hip_cooperative_groups.h>
#include <cstdio>
#include <cstdint>
namespace cg = cooperative_groups;

typedef unsigned short bf16_t;
typedef short bf16x8 __attribute__((ext_vector_type(8)));
typedef short s16x4 __attribute__((ext_vector_type(4)));
typedef float f32x4 __attribute__((ext_vector_type(4)));
typedef float f32x16 __attribute__((ext_vector_type(16)));
typedef __bf16 bf2_t __attribute__((ext_vector_type(2)));
typedef float f2_t __attribute__((ext_vector_type(2)));
#define DI __device__ __forceinline__
#define GAS __attribute__((address_space(1)))
typedef unsigned u32x4 __attribute__((ext_vector_type(4)));

constexpr int T_TOK = 16384, DM = 2048, DFF = 5632, SEQ = 2048, NB = 8;
constexpr float EPS = 1e-6f;
#ifndef LAST_PH
#define LAST_PH 18
#endif
#define DBG_DUMP 0
#define SKEW_ITERS 0
#define N_EXTRA 0
#define EXTRA_PH {30, 99, 99, 99}
#define PROBE_ST 4
#define DBG_OFFS {R_QS, R_KK, R_IT, R_SOG, OFF_OA, OFF_CQ, OFF_CKV, OFF_KPE}
#define DBG_LENS {0, SZ_TD / 2, 0, 0, 0, 0, 0, 0}

constexpr size_t SZ_WIN = 13568ull * 2048 * 2;
constexpr size_t OFF_WIN = 0;
constexpr size_t OFF_WQUP = OFF_WIN + SZ_WIN;
constexpr size_t OFF_WKVUP = OFF_WQUP + 3072ull * 512 * 2;
constexpr size_t OFF_WBRA = OFF_WKVUP + 4096ull * 512 * 2;
constexpr size_t OFF_WBRB = OFF_WBRA + 2048ull * 2048 * 2;
constexpr size_t OFF_WOUT = OFF_WBRB + 2048ull * 2048 * 2;
constexpr size_t OFF_XWQ = OFF_WOUT + 2048ull * 2048 * 2;
constexpr size_t OFF_XWKV = OFF_XWQ + 512ull * 2048 * 2;
constexpr size_t OFF_XWO = OFF_XWKV + 1024ull * 2048 * 2;
constexpr size_t OFF_LB = OFF_XWO + 2048ull * 512 * 2;
constexpr size_t OFF_TAB = OFF_LB + 8192;
constexpr size_t OFF_BAR = OFF_TAB + 512;
constexpr size_t OFF_COS = OFF_BAR + 2048;
constexpr size_t OFF_SIN = OFF_COS + 16384ull * 32 * 4;
constexpr size_t OFF_XAK = OFF_SIN + 16384ull * 32 * 4;
constexpr size_t OFF_XAVT = OFF_XAK + 2048ull * 512 * 2;
constexpr size_t OFF_FFN = OFF_XAVT + 2048ull * 512 * 2;
constexpr size_t SZ_FFN_GU = 11264ull * 2048 * 2;
constexpr size_t SZ_FFN = SZ_FFN_GU + 2048ull * 5632 * 2;
constexpr size_t OFF_H = OFF_FFN + SZ_FFN;
constexpr size_t SZ_TD = 16384ull * 2048 * 2;
constexpr size_t OFF_CQ = OFF_H + SZ_TD;
constexpr size_t OFF_CKV = OFF_CQ + 16384ull * 512 * 2;
constexpr size_t OFF_KPE = OFF_CKV + 16384ull * 512 * 2;
constexpr size_t OFF_OA = OFF_KPE + 16384ull * 64 * 2;
constexpr size_t OFF_R = OFF_OA + SZ_TD;
constexpr size_t WS_END = OFF_R + 4 * SZ_TD;
constexpr size_t R_ACT = OFF_R;
constexpr size_t R_Y = OFF_R + 16384ull * 5632 * 2;
constexpr size_t R_QS = OFF_R, R_KK = OFF_R + SZ_TD, R_IT = OFF_R + 2 * SZ_TD, R_SOG = OFF_R + 3 * SZ_TD;
constexpr size_t R_QF = OFF_R, R_KN = OFF_R + 16384ull * 3072 * 2, R_VT = R_KN + SZ_TD;
constexpr size_t R_GATES = OFF_R, R_YM = OFF_R + 2 * SZ_TD, R_Z = OFF_R + 3 * SZ_TD;
constexpr size_t R_QXA = OFF_R, R_OXA = OFF_R + 16384ull * 512 * 2;

struct Params {
  const float* in[32];
  float* out;
  unsigned char* ws;
  int last_ph; int nextra; int extra[4];
};

DI int lane_id_v() { int l; asm volatile("v_mbcnt_lo_u32_b32 %0, -1, 0\n\tv_mbcnt_hi_u32_b32 %0, -1, %0" : "=v"(l)); return l; }
DI float bf2f(bf16_t v) { return __uint_as_float(((unsigned)v) << 16); }
DI unsigned pk2(float a, float b) { f2_t v = {a, b}; bf2_t r = __builtin_convertvector(v, bf2_t); return __builtin_bit_cast(unsigned, r); }
DI bf16_t f2bf(float a) { return (bf16_t)(pk2(a, 0.f) & 0xffffu); }
DI float lo_f(unsigned u) { return __uint_as_float(u << 16); }
DI float hi_f(unsigned u) { return __uint_as_float(u & 0xffff0000u); }
DI float fexp_(float x) { return __builtin_amdgcn_exp2f(x * 1.4426950408889634f); }
DI float flog_(float x) { return __builtin_amdgcn_logf(x) * 0.6931471805599453f; }
DI float sigmoidf_(float v) { return __builtin_amdgcn_rcpf(1.f + fexp_(-v)); }
DI float siluf_(float v) { return v * sigmoidf_(v); }
DI float wave_sum(float v) {
  v += __shfl_xor(v, 32); v += __shfl_xor(v, 16); v += __shfl_xor(v, 8);
  v += __shfl_xor(v, 4); v += __shfl_xor(v, 2); v += __shfl_xor(v, 1);
  return v;
}

constexpr int BM = 256, BK = 64, HALF = 128, HT = HALF * BK;
enum { M_STORE = 0, M_SWIGLU, M_WIN, M_SIGMOID, M_KVUP, M_BRA, M_BRB, M_XAKV };

struct GemmJob {
  const bf16_t* A; const bf16_t* Bt; int lda; int K; int nM; int nN; int mode; int ldc;
  bf16_t* o0;
};

DI int lds_byte(int r, int c) {
  int st = (r >> 4) * 2 + (c >> 5), rr = r & 15, cc = c & 31, ob = rr * 64 + cc * 2;
  return st * 1024 + (ob ^ (((ob >> 9) & 1) << 5));
}
DI void stage_rc(int b, int& R, int& C) {
  int st = b / 1024, sb = b % 1024, swz = sb ^ (((sb >> 9) & 1) << 5);
  R = (st >> 1) * 16 + swz / 64; C = (st & 1) * 32 + (swz % 64) / 2;
}
DI void tile_map(int L, int nM, int nN, int& pm, int& pn) {
  int nwg = nM * nN, wgid = L;
  { int q = nwg / 8, r = nwg % 8, xcd = wgid % 8, off = wgid / 8; wgid = (xcd < r ? xcd * (q + 1) : r * (q + 1) + (xcd - r) * q) + off; }
  int nig = 8 * nN, gid = wgid / nig, fm = gid * 8, gsz = (nM - fm) < 8 ? (nM - fm) : 8;
  pm = fm + ((wgid % nig) % gsz); pn = (wgid % nig) / gsz;
}

DI void store4(bf16_t* p, f32x4 v) { uint2 u; u.x = pk2(v[0], v[1]); u.y = pk2(v[2], v[3]); *(uint2*)p = u; }

enum { C_STORE = 0, C_SWIGLU, C_SIGMOID, C_SILU, C_KK, C_MLA, C_BRA, C_BRB };
template <int CM, int SH>
DI void copy_rm(const unsigned char* T0, const int tid, unsigned char* ws, bf16_t* rmb, const int rmld, const int rmc0, const int grow0, const int bcol, const bool nostore) {
  constexpr int NIT = (128 << SH) / 512;
  _Pragma("unroll 8") for (int i = 0; i < NIT; ++i) {
    const int it = tid + 512 * i;
    const int row = it >> SH, col = (it & ((1 << SH) - 1)) * 8;
    const unsigned char* rp = T0 + row * 1024; const int sw = (row & 15);
    const f32x4 a0 = *(const f32x4*)(rp + ((((col >> 2)) ^ sw) << 4)), a1 = *(const f32x4*)(rp + ((((col >> 2) + 1) ^ sw) << 4));
    float v[8] = {a0[0], a0[1], a0[2], a0[3], a1[0], a1[1], a1[2], a1[3]};
    const int grow = grow0 + row;
    if (CM == C_SWIGLU) {
      const f32x4 u0 = *(const f32x4*)(rp + ((((col >> 2) + 32) ^ sw) << 4)), u1 = *(const f32x4*)(rp + ((((col >> 2) + 33) ^ sw) << 4));
      _Pragma("unroll") for (int j = 0; j < 4; ++j) { v[j] = siluf_(v[j]) * u0[j]; v[4 + j] = siluf_(v[4 + j]) * u1[j]; }
    } else if (CM == C_SIGMOID) {
      _Pragma("unroll") for (int j = 0; j < 8; ++j) v[j] = sigmoidf_(v[j]);
    } else if (CM == C_SILU) {
      _Pragma("unroll") for (int j = 0; j < 8; ++j) v[j] = siluf_(v[j]);
    } else if (CM == C_KK) {
      const GAS float* lbp = (const GAS float*)(ws + OFF_LB) + (bcol - 2048) + col;
      const f32x4 l0 = *(const GAS f32x4*)lbp, l1 = *(const GAS f32x4*)(lbp + 4);
      _Pragma("unroll") for (int j = 0; j < 4; ++j) { v[j] = (1.f - l0[j]) * sigmoidf_(-v[j]); v[4 + j] = (1.f - l1[j]) * sigmoidf_(-v[4 + j]); }
    } else if (CM == C_BRA || CM == C_BRB) {
      const u32x4 gg = *(const GAS u32x4*)((const bf16_t*)(ws + R_GATES) + (CM == C_BRB ? 2048 : 0) + (long)grow * 4096 + bcol + col);
      v[0] *= lo_f(gg[0]); v[1] *= hi_f(gg[0]); v[2] *= lo_f(gg[1]); v[3] *= hi_f(gg[1]); v[4] *= lo_f(gg[2]); v[5] *= hi_f(gg[2]); v[6] *= lo_f(gg[3]); v[7] *= hi_f(gg[3]);
    }
    bf16_t* dst;
    if (CM == C_MLA) { const int cg_ = bcol - 8192 + col;
      if (cg_ < 512) dst = (bf16_t*)(ws + OFF_CQ) + (long)grow * 512 + cg_;
      else if (cg_ < 1024) dst = (bf16_t*)(ws + OFF_CKV) + (long)grow * 512 + (cg_ - 512);
      else if (cg_ < 1088) dst = (bf16_t*)(ws + OFF_KPE) + (long)grow * 64 + (cg_ - 1024);
      else dst = nullptr;
    } else dst = rmb + (unsigned)(grow * rmld + rmc0 + col);
    if (CM == C_BRB) { const u32x4 y = *(const GAS u32x4*)dst;
      v[0] += lo_f(y[0]); v[1] += hi_f(y[0]); v[2] += lo_f(y[1]); v[3] += hi_f(y[1]); v[4] += lo_f(y[2]); v[5] += hi_f(y[2]); v[6] += lo_f(y[3]); v[7] += hi_f(y[3]); }
    if (CM != C_MLA || dst) { u32x4 o = {pk2(v[0], v[1]), pk2(v[2], v[3]), pk2(v[4], v[5]), pk2(v[6], v[7])}; if (!nostore) *(GAS u32x4*)dst = o; else asm volatile("" :: "v"(o)); }
  }
}

DI void gemm_tile(const int tx, const int wv_s, bf16_t* shm, unsigned char* ws, const GemmJob& J, int pm, int pn, const bool skip_epi) {
  const bf16_t* __restrict__ A = J.A; const bf16_t* __restrict__ Bt = J.Bt;
  const int lda = J.lda, K = J.K;
#define SA(b, h) (shm + ((b) * 2 + (h)) * HT)
#define SB(b, h) (shm + (4 + (b) * 2 + (h)) * HT)
#define STAGE(P, BASE, OFFS, LD, br, kt) do { const char* _base = (const char*)((BASE) + ((long)(br) * (LD) + (long)(kt) * BK)); \
    _Pragma("unroll") for (int _i = 0; _i < 2; ++_i) { \
      __builtin_amdgcn_global_load_lds((const unsigned*)(_base + (unsigned long)OFFS[_i]), \
        (__attribute__((address_space(3))) unsigned*)((char*)(P) + wv_s * 1024 + _i * 8192), 16, 0, 0); } } while (0)
#define LDA(dst, b, h) _Pragma("unroll") for (int m = 0; m < 4; ++m) _Pragma("unroll") for (int k = 0; k < 2; ++k) \
    dst[m][k] = *(const __attribute__((address_space(3))) bf16x8*)(pA + (((b) * 2 + (h)) * 16384 + (m * 2 + k) * 1024))
#define LDB(dst, b, h) _Pragma("unroll") for (int n = 0; n < 2; ++n) _Pragma("unroll") for (int k = 0; k < 2; ++k) \
    dst[n][k] = *(const __attribute__((address_space(3))) bf16x8*)(pB + (((b) * 2 + (h)) * 16384 + (n * 2 + k) * 1024))
#define MMA(ai, bj, At, Bf) do { __builtin_amdgcn_s_setprio(1); \
    _Pragma("unroll") for (int m = 0; m < 4; ++m) _Pragma("unroll") for (int n = 0; n < 2; ++n) _Pragma("unroll") for (int k = 0; k < 2; ++k) \
      acc[ai][bj][m][n] = __builtin_amdgcn_mfma_f32_16x16x32_bf16(Bf[n][k], At[m][k], acc[ai][bj][m][n], 0, 0, 0); \
    __builtin_amdgcn_s_setprio(0); } while (0)
#define WAIT_V(n) asm volatile("s_waitcnt vmcnt(" #n ")" ::: "memory")
#define WAIT_L(n) asm volatile("s_waitcnt lgkmcnt(" #n ")" ::: "memory")
#define BAR __builtin_amdgcn_s_barrier()
#define SCHED __builtin_amdgcn_sched_barrier(0)
  const int brow = pm * BM, bcol = pn * BM;
  const int wid = tx >> 6, lane = tx & 63, wr = wid >> 2, wc = wid & 3, fr = lane & 15, fq = lane >> 4;
  f32x4 acc[2][2][4][2] = {};
  bf16x8 At[4][2], B0[2][2], B1[2][2];
  const int nt = K / BK;
  unsigned offA[2], offB[2];
  _Pragma("unroll") for (int _i = 0; _i < 2; ++_i) { int _r, _c; stage_rc(tx * 16 + _i * 8192, _r, _c); offA[_i] = (unsigned)(_r * lda + _c) * 2u; offB[_i] = (unsigned)(_r * K + _c) * 2u; }
  const int lbx = (fr * 64 + fq * 16) ^ ((fr >> 3) << 5);
  const __attribute__((address_space(3))) unsigned char* pA = (const __attribute__((address_space(3))) unsigned char*)shm + (wr * 8192 + lbx);
  const __attribute__((address_space(3))) unsigned char* pB = (const __attribute__((address_space(3))) unsigned char*)shm + (65536 + wc * 4096 + lbx);
  STAGE(SB(0, 0), Bt, offB, K, bcol, 0); STAGE(SA(0, 0), A, offA, lda, brow, 0);
  STAGE(SB(0, 1), Bt, offB, K, bcol + HALF, 0); STAGE(SA(0, 1), A, offA, lda, brow + HALF, 0);
  if (wr == 1) BAR;
  WAIT_V(4); BAR;
  STAGE(SB(1, 0), Bt, offB, K, bcol, 1); STAGE(SA(1, 0), A, offA, lda, brow, 1); STAGE(SB(1, 1), Bt, offB, K, bcol + HALF, 1);
  WAIT_V(6); BAR;
  for (int t = 0; t < nt - 2; t += 2) {
    LDB(B0, 0, 0); SCHED; LDA(At, 0, 0); STAGE(SA(1, 1), A, offA, lda, brow + HALF, t + 1);
    WAIT_L(8); BAR; WAIT_L(0); MMA(0, 0, At, B0); BAR; SCHED;
    LDB(B1, 0, 1); STAGE(SB(0, 0), Bt, offB, K, bcol, t + 2);
    BAR; WAIT_L(0); MMA(0, 1, At, B1); BAR;
    LDA(At, 0, 1); STAGE(SA(0, 0), A, offA, lda, brow, t + 2);
    BAR; WAIT_L(0); MMA(1, 0, At, B0); BAR; SCHED;
    STAGE(SB(0, 1), Bt, offB, K, bcol + HALF, t + 2);
    WAIT_V(6); BAR; MMA(1, 1, At, B1); BAR;
    LDB(B0, 1, 0); SCHED; LDA(At, 1, 0); STAGE(SA(0, 1), A, offA, lda, brow + HALF, t + 2);
    WAIT_L(8); BAR; WAIT_L(0); MMA(0, 0, At, B0); BAR; SCHED;
    LDB(B1, 1, 1); STAGE(SB(1, 0), Bt, offB, K, bcol, t + 3);
    BAR; WAIT_L(0); MMA(0, 1, At, B1); BAR;
    LDA(At, 1, 1); STAGE(SA(1, 0), A, offA, lda, brow, t + 3);
    BAR; WAIT_L(0); MMA(1, 0, At, B0); BAR; SCHED;
    STAGE(SB(1, 1), Bt, offB, K, bcol + HALF, t + 3);
    WAIT_V(6); BAR; MMA(1, 1, At, B1); BAR;
  }
  { LDB(B0, 0, 0); LDA(At, 0, 0); STAGE(SA(1, 1), A, offA, lda, brow + HALF, nt - 1);
    BAR; WAIT_L(0); MMA(0, 0, At, B0); BAR;
    LDB(B1, 0, 1); BAR; WAIT_L(0); MMA(0, 1, At, B1); BAR;
    LDA(At, 0, 1); WAIT_V(4); BAR; WAIT_L(0); MMA(1, 0, At, B0); MMA(1, 1, At, B1); BAR; }
  { LDB(B0, 1, 0); LDA(At, 1, 0); WAIT_V(2); BAR; WAIT_L(0); MMA(0, 0, At, B0); BAR;
    LDB(B1, 1, 1); WAIT_V(0); BAR; WAIT_L(0); MMA(0, 1, At, B1); BAR;
    LDA(At, 1, 1); BAR; WAIT_L(0); MMA(1, 0, At, B0); MMA(1, 1, At, B1); BAR; }
  if (wr == 0) BAR;
#undef SA
#undef SB
#undef STAGE
#undef LDA
#undef LDB
#undef MMA
  const int mode = J.mode;
  const int grp = pn >> 3;
  unsigned char* T0 = (unsigned char*)shm;
  const int tid = wv_s * 64 + lane_id_v();
  const int wid_e = tid >> 6, lane_e = tid & 63, wr_e = wid_e >> 2, wc_e = wid_e & 3, fr_e = lane_e & 15, fq_e = lane_e >> 4;
  const bool trall = (mode == M_WIN && grp == 2) || (mode == M_XAKV && pn >= 2);
  const int ncol_rm = trall ? 0 : ((mode == M_SWIGLU || mode == M_KVUP) ? 128 : 256);
  const int tr_c0 = trall ? 0 : 128, tr_nc = trall ? 256 : (mode == M_KVUP ? 128 : 0);
  bf16_t* rmb = J.o0; long rmld = J.ldc; int rmc0 = bcol;
  bf16_t* trb = nullptr; long trs = 0;
  if (mode == M_SWIGLU) rmc0 = pn * 128;
  else if (mode == M_KVUP) { rmc0 = pn * 128; trb = (bf16_t*)(ws + R_VT) + ((long)((brow >> 11) * 16 + pn) * 128 - 128) * 2048 + (brow & 2047); trs = 2048; }
  else if (mode == M_XAKV) { trb = (bf16_t*)(ws + OFF_XAVT) + ((long)((brow >> 8) * 4 + (pn - 2) * 2) * 128) * 256; trs = 256; }
  else if (mode == M_WIN) {
    if (grp == 1) { rmb = (bf16_t*)(ws + R_KK); rmc0 = bcol - 2048; }
    else if (grp == 2) { trb = (bf16_t*)(ws + R_IT) + ((long)(brow >> 11) * 2048 + (bcol - 4096)) * 2048 + (brow & 2047); trs = 2048; }
    else if (grp == 3) { rmb = (bf16_t*)(ws + R_SOG); rmc0 = bcol - 6144; }
  }
  const bool mla = (mode == M_WIN && grp >= 4);
  const int sh = (ncol_rm == 128) ? 4 : 5;
  _Pragma("unroll") for (int ai = 0; ai < 2; ++ai) {
    _Pragma("unroll") for (int bj = 0; bj < 2; ++bj) _Pragma("unroll") for (int m = 0; m < 4; ++m) _Pragma("unroll") for (int n = 0; n < 2; ++n) {
      const int row = wr_e * 64 + m * 16 + fr_e, col = bj * 128 + wc_e * 32 + n * 16 + fq_e * 4;
      *(f32x4*)(T0 + row * 1024 + (((col >> 2) ^ (row & 15)) << 4)) = acc[ai][bj][m][n];
    }
    asm volatile("s_waitcnt lgkmcnt(0)" ::: "memory"); __builtin_amdgcn_s_barrier();
    if (!trall) {
      const int g0 = brow + ai * 128, ld32 = (int)rmld;
      if (mode == M_SWIGLU) copy_rm<C_SWIGLU, 4>(T0, tid, ws, rmb, ld32, rmc0, g0, bcol, skip_epi);
      else if (mode == M_STORE || mode == M_XAKV) copy_rm<C_STORE, 5>(T0, tid, ws, rmb, ld32, rmc0, g0, bcol, skip_epi);
      else if (mode == M_KVUP) copy_rm<C_STORE, 4>(T0, tid, ws, rmb, ld32, rmc0, g0, bcol, skip_epi);
      else if (mode == M_SIGMOID) copy_rm<C_SIGMOID, 5>(T0, tid, ws, rmb, ld32, rmc0, g0, bcol, skip_epi);
      else if (mode == M_BRA) copy_rm<C_BRA, 5>(T0, tid, ws, rmb, ld32, rmc0, g0, bcol, skip_epi);
      else if (mode == M_BRB) copy_rm<C_BRB, 5>(T0, tid, ws, rmb, ld32, rmc0, g0, bcol, skip_epi);
      else if (grp == 1) copy_rm<C_KK, 5>(T0, tid, ws, rmb, ld32, rmc0, g0, bcol, skip_epi);
      else if (grp >= 4) copy_rm<C_MLA, 5>(T0, tid, ws, rmb, ld32, rmc0, g0, bcol, skip_epi);
      else copy_rm<C_SILU, 5>(T0, tid, ws, rmb, ld32, rmc0, g0, bcol, skip_epi);
    }
    const int ntr = tr_nc * 16;
    for (int it = tid; it < ntr; it += 512) {
      const int colr = (it >> 7) * 8 + (it & 7), rc = (it >> 3) & 15, col = tr_c0 + colr;
      float v[8];
      _Pragma("unroll") for (int k = 0; k < 8; ++k) { const int row = rc * 8 + k;
        v[k] = *(const float*)(T0 + row * 1024 + ((((col >> 2)) ^ (row & 15)) << 4) + (col & 3) * 4); }
      uint4 o; o.x = pk2(v[0], v[1]); o.y = pk2(v[2], v[3]); o.z = pk2(v[4], v[5]); o.w = pk2(v[6], v[7]);
      { u32x4 ov_ = {o.x, o.y, o.z, o.w}; *(GAS u32x4*)(trb + (long)col * trs + ai * 128 + rc * 8) = ov_; }
    }
    asm volatile("s_waitcnt lgkmcnt(0)" ::: "memory"); __builtin_amdgcn_s_barrier();
  }
}

enum { RM_ID = 0, RM_GATE, RM_UP, RM_WIN };
__device__ __noinline__ void transpose_job(const int tx, float* tile_base, const float* __restrict__ W, int K, int N, bf16_t* dst, int rm, int start, int stride) {
  const int lane = tx & 63, wave = tx >> 6;
  unsigned char* L = (unsigned char*)tile_base + wave * 4608;
  const int tk = K >> 6, tn = N >> 5, nt = tk * tn;
  const int lr = lane >> 3, lc = (lane & 7) * 4;
  for (int t = start * 8 + wave; t < nt; t += stride * 8) {
    const int kt = t % tk, ntile = t / tk, k0 = kt * 64, n0 = ntile * 32;
    f32x4 v[8];
    const float* src = W + (long)(k0 + lr * 2) * N + n0 + lc;
    _Pragma("unroll") for (int i = 0; i < 4; ++i) { v[2 * i] = __builtin_nontemporal_load((const f32x4*)(src + (long)(i * 16) * N)); v[2 * i + 1] = __builtin_nontemporal_load((const f32x4*)(src + (long)(i * 16 + 1) * N)); }
    _Pragma("unroll") for (int i = 0; i < 4; ++i) _Pragma("unroll") for (int j = 0; j < 4; ++j)
      *(unsigned*)(L + (lc + j) * 144 + (i * 16 + lr * 2) * 2) = pk2(v[2 * i][j], v[2 * i + 1][j]);
    asm volatile("s_waitcnt lgkmcnt(0)" ::: "memory");
    _Pragma("unroll") for (int q = 0; q < 4; ++q) {
      const int c = lane + 64 * q, n = c >> 3, kc = c & 7;
      const uint4 val = *(const uint4*)(L + n * 144 + kc * 16);
      const int nn = n0 + n; int drow;
      if (rm == RM_ID) drow = nn; else if (rm == RM_GATE) drow = (nn >> 7) * 256 + (nn & 127);
      else if (rm == RM_UP) drow = (nn >> 7) * 256 + 128 + (nn & 127); else drow = nn < 9280 ? nn : nn + 192;
      *(uint4*)(dst + (long)drow * K + k0 + kc * 8) = val;
    }
    asm volatile("s_waitcnt lgkmcnt(0)" ::: "memory");
  }
}

__device__ __noinline__ void norm_rows(const int tx, const int blk, const int nblk, int nrows, const float* res, const bf16_t* y, const float* pg, float w, float* xout, const float* ng, bf16_t* hout) {
  const int lane = tx & 63;
  const int gw = blk * 8 + (tx >> 6), nw = nblk * 8;
  for (int row = gw; row < nrows; row += nw) {
    f32x4 xv[8];
    const float* rp = res + (long)row * 2048;
    _Pragma("unroll") for (int i = 0; i < 8; ++i) xv[i] = __builtin_nontemporal_load((const f32x4*)(rp + i * 256 + lane * 4));
    if (y) {
      f32x4 yv[8]; float ss = 0.f;
      const bf16_t* yp = y + (long)row * 2048;
      _Pragma("unroll") for (int i = 0; i < 8; ++i) { typedef unsigned u32x2_t __attribute__((ext_vector_type(2))); const u32x2_t u_ = __builtin_nontemporal_load((const u32x2_t*)(yp + i * 256 + lane * 4)); uint2 u; u.x = u_[0]; u.y = u_[1];
        yv[i][0] = lo_f(u.x); yv[i][1] = hi_f(u.x); yv[i][2] = lo_f(u.y); yv[i][3] = hi_f(u.y);
        _Pragma("unroll") for (int j = 0; j < 4; ++j) ss += yv[i][j] * yv[i][j]; }
      ss = wave_sum(ss);
      const float rs = rsqrtf(ss * (1.f / 2048.f) + EPS) * w;
      _Pragma("unroll") for (int i = 0; i < 8; ++i) { f32x4 g = *(const f32x4*)(pg + i * 256 + lane * 4);
        _Pragma("unroll") for (int j = 0; j < 4; ++j) xv[i][j] += yv[i][j] * rs * g[j]; }
    }
    if (xout) { float* op = xout + (long)row * 2048; _Pragma("unroll") for (int i = 0; i < 8; ++i) __builtin_nontemporal_store(xv[i], (f32x4*)(op + i * 256 + lane * 4)); }
    if (hout) {
      float ss = 0.f; _Pragma("unroll") for (int i = 0; i < 8; ++i) _Pragma("unroll") for (int j = 0; j < 4; ++j) ss += xv[i][j] * xv[i][j];
      ss = wave_sum(ss);
      const float rs = rsqrtf(ss * (1.f / 2048.f) + EPS);
      bf16_t* hp = hout + (long)row * 2048;
      _Pragma("unroll") for (int i = 0; i < 8; ++i) { f32x4 g = *(const f32x4*)(ng + i * 256 + lane * 4); f32x4 r;
        _Pragma("unroll") for (int j = 0; j < 4; ++j) r[j] = xv[i][j] * rs * g[j];
        store4(hp + i * 256 + lane * 4, r); }
    }
  }
}

__device__ __noinline__ void mla_prep(const int tx, bf16_t* cq, bf16_t* ckv, bf16_t* kpe, const float* qg, const float* kvg, const float* cosT, const float* sinT, int start_w, int n_w) {
  const int lane = tx & 63;
  for (int row = start_w; row < T_TOK; row += n_w) {
    _Pragma("unroll") for (int which = 0; which < 2; ++which) {
      bf16_t* p = (which ? ckv : cq) + (long)row * 512 + lane * 8; const float* g = (which ? kvg : qg) + lane * 8;
      uint4 u = *(const uint4*)p; float v[8] = {lo_f(u.x), hi_f(u.x), lo_f(u.y), hi_f(u.y), lo_f(u.z), hi_f(u.z), lo_f(u.w), hi_f(u.w)};
      float ss = 0.f; _Pragma("unroll") for (int j = 0; j < 8; ++j) ss += v[j] * v[j];
      ss = wave_sum(ss); const float rs = rsqrtf(ss * (1.f / 512.f) + EPS);
      _Pragma("unroll") for (int j = 0; j < 8; ++j) v[j] = v[j] * rs * g[j];
      u.x = pk2(v[0], v[1]); u.y = pk2(v[2], v[3]); u.z = pk2(v[4], v[5]); u.w = pk2(v[6], v[7]);
      *(uint4*)p = u;
    }
    const int i = lane & 31;
    const float x1 = bf2f(kpe[(long)row * 64 + i]), x2 = bf2f(kpe[(long)row * 64 + 32 + i]);
    const float c = cosT[(long)row * 32 + i], s = sinT[(long)row * 32 + i];
    const float r = (lane < 32) ? (x1 * c - x2 * s) : (x2 * c + x1 * s);
    kpe[(long)row * 64 + lane] = f2bf(r);
  }
}

struct AttnArgs {
  const bf16_t* Q; int ldq; const bf16_t* Kn; int ldk; const bf16_t* Kpe; const bf16_t* VT; bf16_t* O; int ldo;
  const float* cosT; const float* sinT; int H, Sq, Sk; float c;
};
#define MFMA32(a, b, c) __builtin_amdgcn_mfma_f32_32x32x16_bf16((a), (b), (c), 0, 0, 0)

template <int DQK, bool CAUSAL>
DI void attn_unit(const int tx, unsigned char* smem, const AttnArgs& a, int b, int h, int qt) {
  constexpr int KSTR = (DQK + 8) * 2;
  constexpr int VSTR = 68 * 2;
  constexpr int KBUF = 64 * KSTR, VBUF = 128 * VSTR;
  constexpr int NKS = DQK / 16;
  constexpr int KCH = DQK / 8;
  constexpr int NKL = 64 * KCH / 512;
  unsigned char* Ks = smem; unsigned char* Vs = smem + 2 * KBUF;
  const int tid = tx, lane = tid & 63, wave = tid >> 6, r = lane & 31, hh = lane >> 5;
  const long qrow = (long)b * a.Sq + qt * 256 + wave * 32 + r;
  const int xaddr = (lane ^ 32) << 2;
  bf16x8 qf[NKS];
  { const bf16_t* qp = a.Q + qrow * a.ldq + h * DQK + 8 * hh;
    _Pragma("unroll") for (int ks = 0; ks < NKS; ++ks) qf[ks] = *(const bf16x8*)(qp + ks * 16); }
  if (DQK == 192) {
    _Pragma("unroll") for (int ks = 8; ks < 10; ++ks) {
      const int i0 = 16 * (ks - 8) + 8 * hh;
      float cs[8], sn[8];
      { f32x4 c0 = *(const f32x4*)(a.cosT + qrow * 32 + i0), c1 = *(const f32x4*)(a.cosT + qrow * 32 + i0 + 4);
        f32x4 s0 = *(const f32x4*)(a.sinT + qrow * 32 + i0), s1 = *(const f32x4*)(a.sinT + qrow * 32 + i0 + 4);
        _Pragma("unroll") for (int j = 0; j < 4; ++j) { cs[j] = c0[j]; cs[4 + j] = c1[j]; sn[j] = s0[j]; sn[4 + j] = s1[j]; } }
      bf16x8 x1 = qf[ks], x2 = qf[ks + 2], y1, y2;
      _Pragma("unroll") for (int j = 0; j < 8; j += 2) {
        float a0 = bf2f((bf16_t)x1[j]), a1 = bf2f((bf16_t)x1[j + 1]), b0 = bf2f((bf16_t)x2[j]), b1 = bf2f((bf16_t)x2[j + 1]);
        unsigned u1 = pk2(a0 * cs[j] - b0 * sn[j], a1 * cs[j + 1] - b1 * sn[j + 1]);
        unsigned u2 = pk2(b0 * cs[j] + a0 * sn[j], b1 * cs[j + 1] + a1 * sn[j + 1]);
        y1[j] = (short)(u1 & 0xffff); y1[j + 1] = (short)(u1 >> 16); y2[j] = (short)(u2 & 0xffff); y2[j + 1] = (short)(u2 >> 16);
      }
      qf[ks] = y1; qf[ks + 2] = y2;
    }
  }
  const int nkt = CAUSAL ? 4 * (qt + 1) : a.Sk / 64;
  const int kmax = CAUSAL ? 4 * qt + (wave >> 1) : nkt - 1;
  uint4 kr0, kr1, kr2, vr0, vr1;
  kr2 = uint4{0, 0, 0, 0};
  const long krow0 = (long)b * a.Sk;
  const bf16_t* vtb = a.VT + ((long)(b * a.H + h) * 128) * a.Sk;
#define KSRC(i, kt) ({ const int c_ = tid + 512 * (i), row_ = c_ / KCH, cc_ = c_ % KCH; const long tok_ = krow0 + (kt) * 64 + row_; \
    (cc_ < 16) ? (a.Kn + tok_ * a.ldk + h * 128 + cc_ * 8) : (a.Kpe + tok_ * 64 + (cc_ - 16) * 8); })
#define KDST(i, buf) (Ks + (buf) * KBUF + ((tid + 512 * (i)) / KCH) * KSTR + ((tid + 512 * (i)) % KCH) * 16)
#define VSRC(i, kt) (vtb + (long)((tid + 512 * (i)) >> 3) * a.Sk + (kt) * 64 + ((tid + 512 * (i)) & 7) * 8)
#define VDST(i, buf) (Vs + (buf) * VBUF + ((tid + 512 * (i)) >> 3) * VSTR + ((tid + 512 * (i)) & 7) * 16)
#define GLOAD(kt) do { kr0 = *(const uint4*)KSRC(0, kt); kr1 = *(const uint4*)KSRC(1, kt); if (NKL > 2) kr2 = *(const uint4*)KSRC(2, kt); \
    vr0 = *(const uint4*)VSRC(0, kt); vr1 = *(const uint4*)VSRC(1, kt); } while (0)
#define LSTORE(buf) do { *(uint4*)KDST(0, buf) = kr0; *(uint4*)KDST(1, buf) = kr1; if (NKL > 2) *(uint4*)KDST(2, buf) = kr2; \
    *(uint2*)VDST(0, buf) = uint2{vr0.x, vr0.y}; *(uint2*)(VDST(0, buf) + 8) = uint2{vr0.z, vr0.w}; *(uint2*)VDST(1, buf) = uint2{vr1.x, vr1.y}; *(uint2*)(VDST(1, buf) + 8) = uint2{vr1.z, vr1.w}; } while (0)
  f32x16 o[4];
  _Pragma("unroll") for (int mt = 0; mt < 4; ++mt) _Pragma("unroll") for (int i = 0; i < 16; ++i) o[mt][i] = 0.f;
  float m_run = -INFINITY, l_run = 0.f;
  __syncthreads();
  GLOAD(0); LSTORE(0);
  __syncthreads();
  for (int kt = 0; kt < nkt; ++kt) {
    const int buf = kt & 1;
    if (kt + 1 < nkt) GLOAD(kt + 1);
    if (kt <= kmax) {
      f32x16 s0, s1;
      _Pragma("unroll") for (int i = 0; i < 16; ++i) { s0[i] = 0.f; s1[i] = 0.f; }
      const unsigned char* kb = Ks + buf * KBUF + r * KSTR + 16 * hh;
      _Pragma("unroll") for (int kg = 0; kg < NKS; kg += 4) {
        bf16x8 ka0[4], ka1[4];
        _Pragma("unroll") for (int u = 0; u < 4; ++u) { ka0[u] = *(const bf16x8*)(kb + (kg + u) * 32); ka1[u] = *(const bf16x8*)(kb + 32 * KSTR + (kg + u) * 32); }
        _Pragma("unroll") for (int u = 0; u < 4; ++u) { s0 = MFMA32(ka0[u], qf[kg + u], s0); s1 = MFMA32(ka1[u], qf[kg + u], s1); }
      }
      float mx = s0[0];
      _Pragma("unroll") for (int i = 1; i < 16; ++i) mx = fmaxf(mx, s0[i]);
      _Pragma("unroll") for (int i = 0; i < 16; ++i) mx = fmaxf(mx, s1[i]);
      mx = fmaxf(mx, __int_as_float(__builtin_amdgcn_ds_bpermute(xaddr, __float_as_int(mx))));
      const float m_new = fmaxf(m_run, mx);
      const float alpha = __builtin_amdgcn_exp2f((m_run - m_new) * a.c);
      m_run = m_new;
      float ls = 0.f; const float mc = m_new * a.c;
      _Pragma("unroll") for (int i = 0; i < 16; ++i) { s0[i] = __builtin_amdgcn_exp2f(s0[i] * a.c - mc); ls += s0[i]; }
      _Pragma("unroll") for (int i = 0; i < 16; ++i) { s1[i] = __builtin_amdgcn_exp2f(s1[i] * a.c - mc); ls += s1[i]; }
      l_run = l_run * alpha + ls;
      if (__builtin_amdgcn_ballot_w64(alpha != 1.f) != 0ull) { _Pragma("unroll") for (int mt = 0; mt < 4; ++mt) _Pragma("unroll") for (int i = 0; i < 16; ++i) o[mt][i] *= alpha; }
      bf16x8 pf[4];
      _Pragma("unroll") for (int s = 0; s < 4; ++s) {
        unsigned u[4];
        _Pragma("unroll") for (int j = 0; j < 4; ++j) { const int ri = 8 * (s & 1) + 2 * j;
          u[j] = (s < 2) ? pk2(s0[ri], s0[ri + 1]) : pk2(s1[ri], s1[ri + 1]); }
        uint4 uu = {u[0], u[1], u[2], u[3]}; pf[s] = __builtin_bit_cast(bf16x8, uu);
      }
      const unsigned char* vb = Vs + buf * VBUF + r * VSTR + 8 * hh;
      _Pragma("unroll") for (int mt = 0; mt < 4; ++mt) {
        s16x4 lo[4], hi[4];
        _Pragma("unroll") for (int s = 0; s < 4; ++s) { lo[s] = *(const s16x4*)(vb + mt * 32 * VSTR + s * 32); hi[s] = *(const s16x4*)(vb + mt * 32 * VSTR + s * 32 + 16); }
        _Pragma("unroll") for (int s = 0; s < 4; ++s) {
          bf16x8 av = __builtin_shufflevector(lo[s], hi[s], 0, 1, 2, 3, 4, 5, 6, 7);
          o[mt] = MFMA32(av, pf[s], o[mt]);
        }
      }
    }
    if (kt + 1 < nkt) LSTORE(buf ^ 1);
    __syncthreads();
  }
  const float lt = l_run + __int_as_float(__builtin_amdgcn_ds_bpermute(xaddr, __float_as_int(l_run)));
  const float inv = 1.f / lt;
  bf16_t* op = a.O + qrow * a.ldo + h * 128 + 4 * hh;
  _Pragma("unroll") for (int mt = 0; mt < 4; ++mt) _Pragma("unroll") for (int g = 0; g < 4; ++g) {
    f32x4 v = {o[mt][4 * g] * inv, o[mt][4 * g + 1] * inv, o[mt][4 * g + 2] * inv, o[mt][4 * g + 3] * inv};
    store4(op + mt * 32 + 8 * g, v);
  }
}

#undef KSRC
#undef KDST
#undef VSRC
#undef VDST
#undef GLOAD
#undef LSTORE
#define MFMA16(a, b, c) __builtin_amdgcn_mfma_f32_16x16x32_bf16((a), (b), (c), 0, 0, 0)
DI void hgrn_unit(const int tx, unsigned char* smem, const bf16_t* qs, const bf16_t* kk, const bf16_t* iT, const bf16_t* sog, const float* hgg, bf16_t* oa, int b, int h) {
  constexpr int QSTR = 136 * 2, SSTR = 72 * 2, OSTR = 132 * 4;
  unsigned char* QH = smem;
  unsigned char* KH = smem + 17408;
  unsigned char* KHT = smem + 34816;
  unsigned char* VT = smem + 53248;
  unsigned char* PS = smem + 71680;
  unsigned char* ST = smem + 80896;
  float* BT = (float*)(smem + 115712);
  unsigned char* OF = smem + 17408;
  const int tid = tx, lane = tid & 63, w = tid >> 6, fr = lane & 15, fq = lane >> 4;
  const int kcol = tid & 127, sb = tid >> 7;
  f32x4 S[8];
  _Pragma("unroll") for (int i = 0; i < 8; ++i) S[i] = f32x4{0.f, 0.f, 0.f, 0.f};
  __syncthreads();
  unsigned short pk_[16], pq_[16]; uint4 pv0, pv1;
#define HG_LOAD(nn) do { const long t0_ = (long)b * 2048 + (nn) * 64; \
    const bf16_t* kp_ = kk + (t0_ + sb * 16) * 2048 + h * 128 + kcol; const bf16_t* qp_ = qs + (t0_ + sb * 16) * 2048 + h * 128 + kcol; \
    _Pragma("unroll") for (int i = 0; i < 16; ++i) { pk_[i] = kp_[(long)i * 2048]; pq_[i] = qp_[(long)i * 2048]; } \
    pv0 = *(const uint4*)(iT + ((long)(b * 16 + h) * 128 + (tid >> 3)) * 2048 + (nn) * 64 + (tid & 7) * 8); \
    pv1 = *(const uint4*)(iT + ((long)(b * 16 + h) * 128 + 64 + (tid >> 3)) * 2048 + (nn) * 64 + (tid & 7) * 8); } while (0)
  HG_LOAD(0);
  float hgw[16];
  { const int part_ = tid & 7; _Pragma("unroll") for (int i = 0; i < 16; ++i) hgw[i] = hgg[h * 128 + part_ * 16 + i]; }
  _Pragma("unroll 1") for (int n = 0; n < 32; ++n) {
    const long tok0 = (long)b * 2048 + n * 64;
    float cq[16], ck[16], cb[16];
    { float run = 0.f;
      _Pragma("unroll") for (int i = 0; i < 16; ++i) { ck[i] = fminf(fmaxf(bf2f(pk_[i]), 0.f), 0.999f); cq[i] = bf2f(pq_[i]);
        run += flog_(1.f - ck[i]); cb[i] = run; }
      BT[sb * 128 + kcol] = run; }
    *(uint4*)(VT + (tid >> 3) * SSTR + (tid & 7) * 16) = pv0; *(uint4*)(VT + (64 + (tid >> 3)) * SSTR + (tid & 7) * 16) = pv1;
    if (n + 1 < 32) HG_LOAD(n + 1);
    const long sog_off = (tok0 + (tid >> 3)) * 2048 + h * 128 + (tid & 7) * 16;
    const uint4 g0 = *(const uint4*)(sog + sog_off), g1 = *(const uint4*)(sog + sog_off + 8);
    __syncthreads();
    { float pre = 0.f; _Pragma("unroll") for (int j = 0; j < 4; ++j) if (j < sb) pre += BT[j * 128 + kcol];
      const float b31 = BT[kcol] + BT[128 + kcol];
      unsigned kt[8];
      _Pragma("unroll") for (int i = 0; i < 16; i += 2) {
        const float d0 = fminf(fmaxf(pre + cb[i] - b31, -80.f), 80.f), d1 = fminf(fmaxf(pre + cb[i + 1] - b31, -80.f), 80.f);
        const float q0 = cq[i] * fexp_(d0), q1 = cq[i + 1] * fexp_(d1);
        const float k0 = ck[i] * fexp_(-d0), k1 = ck[i + 1] * fexp_(-d1);
        *(bf16_t*)(QH + (sb * 16 + i) * QSTR + kcol * 2) = f2bf(q0); *(bf16_t*)(QH + (sb * 16 + i + 1) * QSTR + kcol * 2) = f2bf(q1);
        const unsigned kp2 = pk2(k0, k1);
        *(bf16_t*)(KH + (sb * 16 + i) * QSTR + kcol * 2) = (bf16_t)(kp2 & 0xffff); *(bf16_t*)(KH + (sb * 16 + i + 1) * QSTR + kcol * 2) = (bf16_t)(kp2 >> 16);
        kt[i >> 1] = kp2;
      }
      *(uint4*)(KHT + kcol * SSTR + sb * 32) = uint4{kt[0], kt[1], kt[2], kt[3]};
      *(uint4*)(KHT + kcol * SSTR + sb * 32 + 16) = uint4{kt[4], kt[5], kt[6], kt[7]};
      float e31[4];
      _Pragma("unroll") for (int j = 0; j < 4; ++j) { const int k = w * 16 + fq * 4 + j; e31[j] = fexp_(BT[k] + BT[128 + k]); }
      _Pragma("unroll") for (int vt = 0; vt < 8; ++vt) { _Pragma("unroll") for (int j = 0; j < 4; ++j) S[vt][j] *= e31[j];
        store4((bf16_t*)(ST + (vt * 16 + fr) * QSTR + (w * 16 + fq * 4) * 2), S[vt]); }
    }
    __syncthreads();
    _Pragma("unroll") for (int tt = 0; tt < 2; ++tt) {
      const int tile = 2 * w + tt, ti = tile >> 2, si = tile & 3;
      f32x4 acc = {0.f, 0.f, 0.f, 0.f};
      if (si <= ti) {
        _Pragma("unroll") for (int st = 0; st < 4; ++st) {
          bf16x8 af = *(const bf16x8*)(KH + (si * 16 + fr) * QSTR + st * 64 + fq * 16);
          bf16x8 bfr = *(const bf16x8*)(QH + (ti * 16 + fr) * QSTR + st * 64 + fq * 16);
          acc = MFMA16(af, bfr, acc);
        }
        const int t = ti * 16 + fr;
        _Pragma("unroll") for (int j = 0; j < 4; ++j) { const int s = si * 16 + fq * 4 + j; if (s > t) acc[j] = 0.f; }
      }
      store4((bf16_t*)(PS + (ti * 16 + fr) * SSTR + (si * 16 + fq * 4) * 2), acc);
    }
    { float e63[4];
      _Pragma("unroll") for (int j = 0; j < 4; ++j) { const int k = w * 16 + fq * 4 + j; e63[j] = fexp_(BT[256 + k] + BT[384 + k]); }
      _Pragma("unroll") for (int vt = 0; vt < 8; ++vt) {
        f32x4 acc = S[vt];
        _Pragma("unroll") for (int st = 0; st < 2; ++st) {
          bf16x8 af = *(const bf16x8*)(KHT + (w * 16 + fr) * SSTR + st * 64 + fq * 16);
          bf16x8 bfr = *(const bf16x8*)(VT + (vt * 16 + fr) * SSTR + st * 64 + fq * 16);
          acc = MFMA16(af, bfr, acc);
        }
        _Pragma("unroll") for (int j = 0; j < 4; ++j) S[vt][j] = acc[j] * e63[j];
      } }
    __syncthreads();
    f32x4 oacc[4];
    _Pragma("unroll") for (int tt = 0; tt < 4; ++tt) {
      f32x4 acc = {0.f, 0.f, 0.f, 0.f};
      _Pragma("unroll") for (int st = 0; st < 2; ++st) {
        bf16x8 af = *(const bf16x8*)(VT + (w * 16 + fr) * SSTR + st * 64 + fq * 16);
        bf16x8 bfr = *(const bf16x8*)(PS + (tt * 16 + fr) * SSTR + st * 64 + fq * 16);
        acc = MFMA16(af, bfr, acc);
      }
      _Pragma("unroll") for (int st = 0; st < PROBE_ST; ++st) {
        bf16x8 af = *(const bf16x8*)(ST + (w * 16 + fr) * QSTR + st * 64 + fq * 16);
        bf16x8 bfr = *(const bf16x8*)(QH + (tt * 16 + fr) * QSTR + st * 64 + fq * 16);
        acc = MFMA16(af, bfr, acc);
      }
      oacc[tt] = acc;
    }
    _Pragma("unroll") for (int tt = 0; tt < 4; ++tt) *(f32x4*)(OF + (tt * 16 + fr) * OSTR + (w * 16 + fq * 4) * 4) = oacc[tt];
    __syncthreads();
    { const int t = tid >> 3, part = tid & 7;
      float ov[16]; float ss = 0.f;
      _Pragma("unroll") for (int i = 0; i < 4; ++i) { f32x4 v = *(const f32x4*)(OF + t * OSTR + (part * 16 + i * 4) * 4);
        _Pragma("unroll") for (int j = 0; j < 4; ++j) { ov[i * 4 + j] = v[j]; ss += v[j] * v[j]; } }
      ss += __int_as_float(__builtin_amdgcn_ds_swizzle(__float_as_int(ss), 0x041f)); ss += __int_as_float(__builtin_amdgcn_ds_swizzle(__float_as_int(ss), 0x081f)); ss += __int_as_float(__builtin_amdgcn_ds_swizzle(__float_as_int(ss), 0x101f));
      const float rs = rsqrtf(ss * (1.f / 128.f) + EPS);
      const long off = (tok0 + t) * 2048 + h * 128 + part * 16;
      const unsigned gu[8] = {g0.x, g0.y, g0.z, g0.w, g1.x, g1.y, g1.z, g1.w};
      unsigned ru[8];
      _Pragma("unroll") for (int i = 0; i < 8; ++i) { const float w0 = hgw[2 * i], w1 = hgw[2 * i + 1];
        ru[i] = pk2(ov[2 * i] * rs * w0 * lo_f(gu[i]), ov[2 * i + 1] * rs * w1 * hi_f(gu[i])); }
      *(uint4*)(oa + off) = uint4{ru[0], ru[1], ru[2], ru[3]}; *(uint4*)(oa + off + 8) = uint4{ru[4], ru[5], ru[6], ru[7]};
    }
  }
}

struct JobD { unsigned long long a_off, b_off, o_off; int lda, K, nM, nN, mode, ldc; };
__constant__ JobD g_jobs[12] = {
    {OFF_H, OFF_FFN, R_ACT, 2048, 2048, 64, 44, M_SWIGLU, DFF},
    {R_ACT, OFF_FFN + SZ_FFN_GU, R_Y, DFF, DFF, 64, 8, M_STORE, 2048},
    {OFF_H, OFF_WIN, R_QS, 2048, 2048, 64, 37, M_WIN, 2048},
    {OFF_OA, OFF_XWKV, OFF_XAK, 2048, 2048, 8, 4, M_XAKV, 512},
    {OFF_CQ, OFF_WQUP, R_QF, 512, 512, 64, 12, M_STORE, 3072},
    {OFF_CKV, OFF_WKVUP, R_KN, 512, 512, 64, 16, M_KVUP, 2048},
    {OFF_H, OFF_WIN + 37ull * 256 * 2048 * 2, R_GATES, 2048, 2048, 64, 16, M_SIGMOID, 4096},
    {OFF_OA, OFF_WBRA, R_YM, 2048, 2048, 64, 8, M_BRA, 2048},
    {OFF_FFN, OFF_WBRB, R_YM, 2048, 2048, 64, 8, M_BRB, 2048},
    {R_YM, OFF_WOUT, R_Z, 2048, 2048, 64, 8, M_STORE, 2048},
    {OFF_H, OFF_XWQ, R_QXA, 2048, 2048, 64, 2, M_STORE, 512},
    {R_OXA, OFF_XWO, R_Z, 512, 512, 64, 8, M_STORE, 2048},
};
__constant__ int g_phase_jobs[19][3] = {
  {-1,-1,0}, {0,-1,0}, {1,-1,0}, {-1,-1,0}, {2,3,0}, {-1,-1,0}, {4,5,0}, {-1,-1,0}, {6,-1,0}, {7,8,1}, {9,-1,0},
  {-1,-1,0}, {10,-1,0}, {-1,-1,0}, {11,-1,0}, {-1,-1,0}, {0,-1,0}, {1,-1,0}, {-1,-1,0} };
#define WSB(off) ((bf16_t*)(ws + (off)))
DI void gemm_phase(const int wave_s, const int blk, const int nblk, unsigned char* ws, int ph, const bool skip_epi) {
  extern __shared__ __attribute__((aligned(16))) unsigned char smem[];
  bf16_t* shm = (bf16_t*)smem;
  const int ja = g_phase_jobs[ph][0], jb = g_phase_jobs[ph][1]; const bool pair = g_phase_jobs[ph][2] != 0;
  const int n0 = g_jobs[ja].nM * g_jobs[ja].nN;
  const int n1 = (jb >= 0 && !pair) ? g_jobs[jb].nM * g_jobs[jb].nN : 0;
  const int total = n0 + n1, nsub = pair ? 2 : 1;
  if (total >= 4 * nblk && (blk & 8)) { for (int i = 0; i < SKEW_ITERS; ++i) __builtin_amdgcn_s_sleep(127); }
  for (int L = blk; L < total; L += nblk) for (int sub = 0; sub < nsub; ++sub) {
    const bool second = pair ? (sub == 1) : (L >= n0);
    const JobD& D = g_jobs[second ? jb : ja];
    GemmJob J; J.A = WSB(D.a_off); J.Bt = WSB(D.b_off); J.o0 = WSB(D.o_off); J.lda = D.lda; J.K = D.K; J.nM = D.nM; J.nN = D.nN; J.mode = D.mode; J.ldc = D.ldc;
    const int l = (pair || !second) ? L : L - n0;
    int pm, pn; tile_map(l, J.nM, J.nN, pm, pn);
    const int txl = wave_s * 64 + lane_id_v();
    gemm_tile(txl, wave_s, shm, ws, J, pm, pn, skip_epi);
  }
}
DI void hgrn_phase(const int tx, const int blk, const int nblk, unsigned char* ws, const float* hgg) {
  extern __shared__ __attribute__((aligned(16))) unsigned char smem[];
  for (int u = blk; u < 128; u += nblk) hgrn_unit(tx, smem, WSB(R_QS), WSB(R_KK), WSB(R_IT), WSB(R_SOG), hgg, WSB(OFF_OA), u >> 4, u & 15);
}
DI void mla_attn_phase(const int tx, const int blk, const int nblk, unsigned char* ws) {
  extern __shared__ __attribute__((aligned(16))) unsigned char smem[];
  AttnArgs a; a.Q = WSB(R_QF); a.ldq = 3072; a.Kn = WSB(R_KN); a.ldk = 2048; a.Kpe = WSB(OFF_KPE); a.VT = WSB(R_VT); a.O = WSB(OFF_FFN); a.ldo = 2048;
  a.cosT = (const float*)(ws + OFF_COS); a.sinT = (const float*)(ws + OFF_SIN); a.H = 16; a.Sq = 2048; a.Sk = 2048; a.c = 0.07216878364870322f * 1.4426950408889634f;
  const bool xmap = (nblk == 256);
  for (int it = blk, s_ = 0; it < 1024; it += nblk, ++s_) {
    int bh = it & 127, qt;
    { const int j = it >> 7; qt = (0x54236710u >> (4 * j)) & 7; }
    if (xmap) { const int x = blk & 7, i = blk >> 3, g = i >> 3, p = i & 7, q = (p + 4) & 7;
      bh = s_ * 32 + g * 8 + x; qt = (s_ == 0) ? p : (s_ == 1) ? 7 - p : (s_ == 2) ? q : 7 - q; }
    const int txl = (tx & ~63) + lane_id_v();
    attn_unit<192, true>(txl, smem, a, bh >> 4, bh & 15, qt); }
}
DI void xa_attn_phase(const int tx, const int blk, const int nblk, unsigned char* ws) {
  extern __shared__ __attribute__((aligned(16))) unsigned char smem[];
  AttnArgs a; a.Q = WSB(R_QXA); a.ldq = 512; a.Kn = WSB(OFF_XAK); a.ldk = 512; a.Kpe = nullptr; a.VT = WSB(OFF_XAVT); a.O = WSB(R_OXA); a.ldo = 512;
  a.cosT = nullptr; a.sinT = nullptr; a.H = 4; a.Sq = 2048; a.Sk = 256; a.c = 0.08838834764831845f * 1.4426950408889634f;
  for (int it = blk; it < 256; it += nblk) { const int txl = (tx & ~63) + lane_id_v(); attn_unit<128, false>(txl, smem, a, it >> 5, (it >> 3) & 3, it & 7); }
}
DI void prologue_phase(const int tx, const int blk, const int nblk, const Params& p) {
  extern __shared__ __attribute__((aligned(16))) unsigned char smem[];
  unsigned char* ws = p.ws;
  float* lbp = (float*)(ws + OFF_LB); float* cosT = (float*)(ws + OFF_COS); float* sinT = (float*)(ws + OFF_SIN);
  const int tid = tx, gtid = blk * 512 + tid, gthreads = nblk * 512;
  float* tile = (float*)smem;
  if (tid < 33) ((const float**)(ws + OFF_TAB))[tid] = (tid < 32) ? p.in[tid] : (const float*)p.out;
  transpose_job(tid, tile, p.in[5], 2048, 5632, WSB(OFF_FFN), RM_GATE, blk, nblk);
  transpose_job(tid, tile, p.in[6], 2048, 5632, WSB(OFF_FFN), RM_UP, blk, nblk);
  transpose_job(tid, tile, p.in[7], 5632, 2048, WSB(OFF_FFN + SZ_FFN_GU), RM_ID, blk, nblk);
  transpose_job(tid, tile, p.in[10], 2048, 13376, WSB(OFF_WIN), RM_WIN, blk, nblk);
  transpose_job(tid, tile, p.in[13], 512, 3072, WSB(OFF_WQUP), RM_ID, blk, nblk);
  transpose_job(tid, tile, p.in[15], 512, 4096, WSB(OFF_WKVUP), RM_ID, blk, nblk);
  transpose_job(tid, tile, p.in[16], 2048, 2048, WSB(OFF_WBRA), RM_ID, blk, nblk);
  transpose_job(tid, tile, p.in[17], 2048, 2048, WSB(OFF_WBRB), RM_ID, blk, nblk);
  transpose_job(tid, tile, p.in[18], 2048, 2048, WSB(OFF_WOUT), RM_ID, blk, nblk);
  transpose_job(tid, tile, p.in[22], 2048, 512, WSB(OFF_XWQ), RM_ID, blk, nblk);
  transpose_job(tid, tile, p.in[23], 2048, 512, WSB(OFF_XWKV), RM_ID, blk, nblk);
  transpose_job(tid, tile, p.in[24], 2048, 512, WSB(OFF_XWKV) + 512 * 2048, RM_ID, blk, nblk);
  transpose_job(tid, tile, p.in[25], 512, 2048, WSB(OFF_XWO), RM_ID, blk, nblk);
  { uint4* z = (uint4*)(WSB(OFF_WIN) + 9280ull * 2048); const int n16 = 192 * 2048 * 2 / 16;
    const unsigned zv = (unsigned)tid >> 31;
    for (int i = gtid; i < n16; i += gthreads) z[i] = uint4{zv, zv, zv, zv}; }
  { const float* lg = p.in[3]; for (int i = gtid; i < 2048; i += gthreads) lbp[i] = 1.f / (1.f + fexp_(lg[2048 + i] - lg[i])); }
  { const int* pos = (const int*)p.in[2];
    for (int i = gtid; i < T_TOK * 32; i += gthreads) { const int row = i >> 5, f = i & 31;
      const float inv_freq = 1.0f / powf(10000.f, (float)(2 * f) / 64.f);
      const float ang = (float)pos[row] * inv_freq;
      const double rev = (double)ang * 0.15915494309189533577;
      const float fr_ = (float)(rev - rint(rev));
      cosT[i] = __builtin_amdgcn_cosf(fr_); sinT[i] = __builtin_amdgcn_sinf(fr_); } }
  norm_rows(tid, blk, nblk, T_TOK, p.in[0], nullptr, nullptr, 0.f, nullptr, p.in[4], WSB(OFF_H));
  norm_rows(tid, blk, nblk, 2048, p.in[1], nullptr, nullptr, 0.f, nullptr, p.in[21], WSB(OFF_OA));
}

__global__ void __launch_bounds__(512) mega(Params p) {
  extern __shared__ __attribute__((aligned(16))) unsigned char smem[];
  cg::grid_group grid = cg::this_grid();
  unsigned char* ws0 = p.ws;
#define TIN(i) (((const float* const*)(ws + OFF_TAB))[i])
#define TOUT ((float*)(((const float* const*)(ws + OFF_TAB))[32]))
  const int nblk0 = gridDim.x, blk0 = blockIdx.x;
  const int wave_s = __builtin_amdgcn_readfirstlane((int)(threadIdx.x >> 6));
  unsigned* bar_cnt = (unsigned*)(ws0 + OFF_BAR);
  if (blk0 == 0 && threadIdx.x == 0) __hip_atomic_store(bar_cnt + 8, 0u, __ATOMIC_RELAXED, __HIP_MEMORY_SCOPE_AGENT);
  grid.sync();
  const int last_ph = p.last_ph + p.nextra;
  const int ex0 = p.extra[0], ex1 = p.extra[1], ex2 = p.extra[2], ex3 = p.extra[3];
  for (int step = 0; step <= last_ph; ++step) {
    const int ph = step <= 18 ? step : (step == 19 ? ex0 : step == 20 ? ex1 : step == 21 ? ex2 : ex3);
    unsigned char* ws = ws0;
    int blk = blk0, nblk = nblk0;
    asm volatile("" : "+s"(ws), "+s"(blk), "+s"(nblk));
    const int tid = wave_s * 64 + lane_id_v();
    if (ph == 0) prologue_phase(tid, blk, nblk, p);
    else if (ph == 3) norm_rows(tid, blk, nblk, T_TOK, TIN(0), WSB(R_Y), TIN(8), 0.5f, TOUT, TIN(9), WSB(OFF_H));
    else if (ph == 5) {
      if (blk < 128) hgrn_phase(tid, blk, nblk, ws, TIN(11));
      const bool split = nblk > 128;
      if (!split || blk >= 128)
        mla_prep(tid, WSB(OFF_CQ), WSB(OFF_CKV), WSB(OFF_KPE), TIN(12), TIN(14), (const float*)(ws + OFF_COS), (const float*)(ws + OFF_SIN),
                 (split ? blk - 128 : blk) * 8 + (tid >> 6), (split ? nblk - 128 : nblk) * 8);
    } else if (ph == 7) mla_attn_phase(tid, blk, nblk, ws);
    else if (ph == 11) {
      norm_rows(tid, blk, nblk, T_TOK, TOUT, WSB(R_Z), TIN(19), 1.0f, TOUT, TIN(20), WSB(OFF_H));
      float* tile = (float*)smem;
      transpose_job(tid, tile, TIN(28), 2048, 5632, WSB(OFF_FFN), RM_GATE, blk, nblk);
      transpose_job(tid, tile, TIN(29), 2048, 5632, WSB(OFF_FFN), RM_UP, blk, nblk);
      transpose_job(tid, tile, TIN(30), 5632, 2048, WSB(OFF_FFN + SZ_FFN_GU), RM_ID, blk, nblk);
    } else if (ph == 13) xa_attn_phase(tid, blk, nblk, ws);
    else if (ph == 15) norm_rows(tid, blk, nblk, T_TOK, TOUT, WSB(R_Z), TIN(26), 1.0f, TOUT, TIN(27), WSB(OFF_H));
    else if (ph == 30) norm_rows(tid, blk, nblk, T_TOK, TOUT, WSB(R_Z), TIN(26), 1.0f, nullptr, TIN(27), WSB(OFF_H));
    else if (ph == 18) norm_rows(tid, blk, nblk, T_TOK, TOUT, WSB(R_Y), TIN(31), 0.5f, TOUT, nullptr, nullptr);
    else if (ph < 19) gemm_phase(wave_s, blk, nblk, ws, ph, false);
    if (step < last_ph) {
      asm volatile("s_waitcnt vmcnt(0) lgkmcnt(0)" ::: "memory");
      __syncthreads();
      if (wave_s == 0 && lane_id_v() == 0) {
        __builtin_amdgcn_fence(__ATOMIC_RELEASE, "agent");
        asm volatile("s_waitcnt vmcnt(0)" ::: "memory");
        const unsigned ng = (nblk % 16 == 0) ? 16u : 1u, gsz = (unsigned)nblk / ng, grp_ = (unsigned)blk % ng;
        const unsigned old_ = __hip_atomic_fetch_add(bar_cnt + 16 * (1 + grp_), 1u, __ATOMIC_RELAXED, __HIP_MEMORY_SCOPE_AGENT);
        if (old_ + 1u == (unsigned)(step + 1) * gsz) __hip_atomic_fetch_add(bar_cnt, 1u, __ATOMIC_RELAXED, __HIP_MEMORY_SCOPE_AGENT);
        const unsigned target = (unsigned)(step + 1) * ng;
        while (__hip_atomic_load(bar_cnt, __ATOMIC_RELAXED, __HIP_MEMORY_SCOPE_AGENT) < target) __builtin_amdgcn_s_sleep(1);
        __builtin_amdgcn_fence(__ATOMIC_ACQUIRE, "agent");
        asm volatile("s_waitcnt vmcnt(0)" ::: "memory");
      }
      __syncthreads();
    }
  }
#if DBG_DUMP
  {
    unsigned char* ws = ws0;
    __threadfence(); __syncthreads();
    if (wave_s == 0 && lane_id_v() == 0) {
      __hip_atomic_fetch_add(bar_cnt, 1u, __ATOMIC_RELEASE, __HIP_MEMORY_SCOPE_AGENT);
      const unsigned target = (unsigned)(last_ph + 1) * (unsigned)nblk0;
      while (__hip_atomic_load(bar_cnt, __ATOMIC_ACQUIRE, __HIP_MEMORY_SCOPE_AGENT) < target) __builtin_amdgcn_s_sleep(2);
    }
    __syncthreads(); __threadfence();
    const size_t offs[8] = DBG_OFFS; const size_t lens[8] = DBG_LENS;
    float* o = (float*)(((const float* const*)(ws + OFF_TAB))[32]);
    const int tid = wave_s * 64 + lane_id_v();
    for (long i = (long)blk0 * 512 + tid; i < (long)T_TOK * 2048; i += (long)nblk0 * 512) {
      float acc = 0.f;
      for (int k = 0; k < 8; ++k) if (lens[k]) { float v = bf2f(((const bf16_t*)(ws + offs[k]))[i % lens[k]]); { const int rr = (int)((i >> 11) & 2047), cc = (int)(i & 2047); v = (fabsf(v) > 1.001f) ? (rr < 2 ? 1000.f : (rr < 4 ? 3000.f : 9000.f)) : 0.f; } acc += v; }
      o[i] = acc;
    }
  }
#endif
}

extern "C" void kernel_launch(void* const* d_in, const int* in_sizes, int n_in,
                              void* d_out, int out_size, void* d_ws, size_t ws_size,
                              hipStream_t stream) {
  constexpr size_t kDynLds = 131072;
  static int grid_blocks = 0;
  if (!grid_blocks) {
    if (n_in != 32 || ws_size < WS_END) { fprintf(stderr, "kernel_launch: need 32 inputs and %zu ws bytes (got %d, %zu)\n", (size_t)WS_END, n_in, ws_size); grid_blocks = -1; return; }
    int dev = 0, cus = 0, per_cu = 0;
    (void)hipGetDevice(&dev);
    (void)hipDeviceGetAttribute(&cus, hipDeviceAttributeMultiprocessorCount, dev);
    (void)hipFuncSetAttribute((const void*)mega, hipFuncAttributeMaxDynamicSharedMemorySize, (int)kDynLds);
    (void)hipOccupancyMaxActiveBlocksPerMultiprocessor(&per_cu, (const void*)mega, 512, kDynLds);
    if (per_cu < 1) per_cu = 1;
    if (per_cu > 1) per_cu = 1;
    grid_blocks = cus * per_cu;
  }
  if (grid_blocks < 0) return;
  (void)hipMemsetAsync((unsigned char*)d_ws + OFF_BAR, 0, 2048, stream);
  Params p{};
  _Pragma("unroll") for (int i = 0; i < 32; ++i) p.in[i] = (const float*)d_in[i];
  p.out = (float*)d_out;
  p.ws = (unsigned char*)d_ws;
  p.last_ph = LAST_PH;
  { const int ex[4] = EXTRA_PH; p.nextra = N_EXTRA; for (int i = 0; i < 4; ++i) p.extra[i] = ex[i]; }
  void* args[] = {&p};
  hipError_t e = hipLaunchCooperativeKernel((const void*)mega, dim3(grid_blocks), dim3(512), args, kDynLds, stream);
  if (e != hipSuccess) fprintf(stderr, "coop launch failed: %s\n", hipGetErrorString(e));
}
```

```cpp
#include <hip/hip_runtime.h>
#include <hip/hip_cooperative_groups.h>
#include <cstdio>
#include <cstdint>
namespace cg = cooperative_groups;

typedef unsigned short bf16_t;
typedef short bf16x8 __attribute__((ext_vector_type(8)));
typedef short s16x4 __attribute__((ext_vector_type(4)));
typedef float f32x4 __attribute__((ext_vector_type(4)));
typedef float f32x16 __attribute__((ext_vector_type(16)));
typedef __bf16 bf2_t __attribute__((ext_vector_type(2)));
typedef float f2_t __attribute__((ext_vector_type(2)));
#define DI __device__ __forceinline__
#define GAS __attribute__((address_space(1)))
typedef unsigned u32x4 __attribute__((ext_vector_type(4)));

constexpr int T_TOK = 16384, DM = 2048, DFF = 5632, SEQ = 2048, NB = 8;
constexpr float EPS = 1e-6f;
#ifndef LAST_PH
#define LAST_PH 18
#endif
#define DBG_DUMP 0
#define SKEW_ITERS 0
#define N_EXTRA 0
#define EXTRA_PH {30, 99, 99, 99}
#define PROBE_ST 4
#define DBG_OFFS {R_QS, R_KK, R_IT, R_SOG, OFF_OA, OFF_CQ, OFF_CKV, OFF_KPE}
#define DBG_LENS {0, SZ_TD / 2, 0, 0, 0, 0, 0, 0}

constexpr size_t SZ_WIN = 13568ull * 2048 * 2;
constexpr size_t OFF_WIN = 0;
constexpr size_t OFF_WQUP = OFF_WIN + SZ_WIN;
constexpr size_t OFF_WKVUP = OFF_WQUP + 3072ull * 512 * 2;
constexpr size_t OFF_WBRA = OFF_WKVUP + 4096ull * 512 * 2;
constexpr size_t OFF_WBRB = OFF_WBRA + 2048ull * 2048 * 2;
constexpr size_t OFF_WOUT = OFF_WBRB + 2048ull * 2048 * 2;
constexpr size_t OFF_XWQ = OFF_WOUT + 2048ull * 2048 * 2;
constexpr size_t OFF_XWKV = OFF_XWQ + 512ull * 2048 * 2;
constexpr size_t OFF_XWO = OFF_XWKV + 1024ull * 2048 * 2;
constexpr size_t OFF_LB = OFF_XWO + 2048ull * 512 * 2;
constexpr size_t OFF_TAB = OFF_LB + 8192;
constexpr size_t OFF_BAR = OFF_TAB + 512;
constexpr size_t OFF_COS = OFF_BAR + 2048;
constexpr size_t OFF_SIN = OFF_COS + 16384ull * 32 * 4;
constexpr size_t OFF_XAK = OFF_SIN + 16384ull * 32 * 4;
constexpr size_t OFF_XAVT = OFF_XAK + 2048ull * 512 * 2;
constexpr size_t OFF_FFN = OFF_XAVT + 2048ull * 512 * 2;
constexpr size_t SZ_FFN_GU = 11264ull * 2048 * 2;
constexpr size_t SZ_FFN = SZ_FFN_GU + 2048ull * 5632 * 2;
constexpr size_t OFF_H = OFF_FFN + SZ_FFN;
constexpr size_t SZ_TD = 16384ull * 2048 * 2;
constexpr size_t OFF_CQ = OFF_H + SZ_TD;
constexpr size_t OFF_CKV = OFF_CQ + 16384ull * 512 * 2;
constexpr size_t OFF_KPE = OFF_CKV + 16384ull * 512 * 2;
constexpr size_t OFF_OA = OFF_KPE + 16384ull * 64 * 2;
constexpr size_t OFF_R = OFF_OA + SZ_TD;
constexpr size_t WS_END = OFF_R + 4 * SZ_TD;
constexpr size_t R_ACT = OFF_R;
constexpr size_t R_Y = OFF_R + 16384ull * 5632 * 2;
constexpr size_t R_QS = OFF_R, R_KK = OFF_R + SZ_TD, R_IT = OFF_R + 2 * SZ_TD, R_SOG = OFF_R + 3 * SZ_TD;
constexpr size_t R_QF = OFF_R, R_KN = OFF_R + 16384ull * 3072 * 2, R_VT = R_KN + SZ_TD;
constexpr size_t R_GATES = OFF_R, R_YM = OFF_R + 2 * SZ_TD, R_Z = OFF_R + 3 * SZ_TD;
constexpr size_t R_QXA = OFF_R, R_OXA = OFF_R + 16384ull * 512 * 2;

struct Params {
  const float* in[32];
  float* out;
  unsigned char* ws;
  int last_ph; int nextra; int extra[4];
};

DI int lane_id_v() { int l; asm volatile("v_mbcnt_lo_u32_b32 %0, -1, 0\n\tv_mbcnt_hi_u32_b32 %0, -1, %0" : "=v"(l)); return l; }
DI float bf2f(bf16_t v) { return __uint_as_float(((unsigned)v) << 16); }
DI unsigned pk2(float a, float b) { f2_t v = {a, b}; bf2_t r = __builtin_convertvector(v, bf2_t); return __builtin_bit_cast(unsigned, r); }
DI bf16_t f2bf(float a) { return (bf16_t)(pk2(a, 0.f) & 0xffffu); }
DI float lo_f(unsigned u) { return __uint_as_float(u << 16); }
DI float hi_f(unsigned u) { return __uint_as_float(u & 0xffff0000u); }
DI float fexp_(float x) { return __builtin_amdgcn_exp2f(x * 1.4426950408889634f); }
DI float flog_(float x) { return __builtin_amdgcn_logf(x) * 0.6931471805599453f; }
DI float sigmoidf_(float v) { return __builtin_amdgcn_rcpf(1.f + fexp_(-v)); }
DI float siluf_(float v) { return v * sigmoidf_(v); }
DI float wave_sum(float v) {
  v += __shfl_xor(v, 32); v += __shfl_xor(v, 16); v += __shfl_xor(v, 8);
  v += __shfl_xor(v, 4); v += __shfl_xor(v, 2); v += __shfl_xor(v, 1);
  return v;
}

constexpr int BM = 256, BK = 64, HALF = 128, HT = HALF * BK;
enum { M_STORE = 0, M_SWIGLU, M_WIN, M_SIGMOID, M_KVUP, M_BRA, M_BRB, M_XAKV };

struct GemmJob {
  const bf16_t* A; const bf16_t* Bt; int lda; int K; int nM; int nN; int mode; int ldc;
  bf16_t* o0;
};

DI int lds_byte(int r, int c) {
  int st = (r >> 4) * 2 + (c >> 5), rr = r & 15, cc = c & 31, ob = rr * 64 + cc * 2;
  return st * 1024 + (ob ^ (((ob >> 9) & 1) << 5));
}
DI void stage_rc(int b, int& R, int& C) {
  int st = b / 1024, sb = b % 1024, swz = sb ^ (((sb >> 9) & 1) << 5);
  R = (st >> 1) * 16 + swz / 64; C = (st & 1) * 32 + (swz % 64) / 2;
}
DI void tile_map(int L, int nM, int nN, int& pm, int& pn) {
  int nwg = nM * nN, wgid = L;
  { int q = nwg / 8, r = nwg % 8, xcd = wgid % 8, off = wgid / 8; wgid = (xcd < r ? xcd * (q + 1) : r * (q + 1) + (xcd - r) * q) + off; }
  int nig = 8 * nN, gid = wgid / nig, fm = gid * 8, gsz = (nM - fm) < 8 ? (nM - fm) : 8;
  pm = fm + ((wgid % nig) % gsz); pn = (wgid % nig) / gsz;
}

DI void store4(bf16_t* p, f32x4 v) { uint2 u; u.x = pk2(v[0], v[1]); u.y = pk2(v[2], v[3]); *(uint2*)p = u; }

enum { C_STORE = 0, C_SWIGLU, C_SIGMOID, C_SILU, C_KK, C_MLA, C_BRA, C_BRB };
template <int CM, int SH>
DI void copy_rm(const unsigned char* T0, const int tid, unsigned char* ws, bf16_t* rmb, const int rmld, const int rmc0, const int grow0, const int bcol, const bool nostore) {
  constexpr int NIT = (128 << SH) / 512;
  _Pragma("unroll 8") for (int i = 0; i < NIT; ++i) {
    const int it = tid + 512 * i;
    const int row = it >> SH, col = (it & ((1 << SH) - 1)) * 8;
    const unsigned char* rp = T0 + row * 1024; const int sw = (row & 15);
    const f32x4 a0 = *(const f32x4*)(rp + ((((col >> 2)) ^ sw) << 4)), a1 = *(const f32x4*)(rp + ((((col >> 2) + 1) ^ sw) << 4));
    float v[8] = {a0[0], a0[1], a0[2], a0[3], a1[0], a1[1], a1[2], a1[3]};
    const int grow = grow0 + row;
    if (CM == C_SWIGLU) {
      const f32x4 u0 = *(const f32x4*)(rp + ((((col >> 2) + 32) ^ sw) << 4)), u1 = *(const f32x4*)(rp + ((((col >> 2) + 33) ^ sw) << 4));
      _Pragma("unroll") for (int j = 0; j < 4; ++j) { v[j] = siluf_(v[j]) * u0[j]; v[4 + j] = siluf_(v[4 + j]) * u1[j]; }
    } else if (CM == C_SIGMOID) {
      _Pragma("unroll") for (int j = 0; j < 8; ++j) v[j] = sigmoidf_(v[j]);
    } else if (CM == C_SILU) {
      _Pragma("unroll") for (int j = 0; j < 8; ++j) v[j] = siluf_(v[j]);
    } else if (CM == C_KK) {
      const GAS float* lbp = (const GAS float*)(ws + OFF_LB) + (bcol - 2048) + col;
      const f32x4 l0 = *(const GAS f32x4*)lbp, l1 = *(const GAS f32x4*)(lbp + 4);
      _Pragma("unroll") for (int j = 0; j < 4; ++j) { v[j] = (1.f - l0[j]) * sigmoidf_(-v[j]); v[4 + j] = (1.f - l1[j]) * sigmoidf_(-v[4 + j]); }
    } else if (CM == C_BRA || CM == C_BRB) {
      const u32x4 gg = *(const GAS u32x4*)((const bf16_t*)(ws + R_GATES) + (CM == C_BRB ? 2048 : 0) + (long)grow * 4096 + bcol + col);
      v[0] *= lo_f(gg[0]); v[1] *= hi_f(gg[0]); v[2] *= lo_f(gg[1]); v[3] *= hi_f(gg[1]); v[4] *= lo_f(gg[2]); v[5] *= hi_f(gg[2]); v[6] *= lo_f(gg[3]); v[7] *= hi_f(gg[3]);
    }
    bf16_t* dst;
    if (CM == C_MLA) { const int cg_ = bcol - 8192 + col;
      if (cg_ < 512) dst = (bf16_t*)(ws + OFF_CQ) + (long)grow * 512 + cg_;
      else if (cg_ < 1024) dst = (bf16_t*)(ws + OFF_CKV) + (long)grow * 512 + (cg_ - 512);
      else if (cg_ < 1088) dst = (bf16_t*)(ws + OFF_KPE) + (long)grow * 64 + (cg_ - 1024);
      else dst = nullptr;
    } else dst = rmb + (unsigned)(grow * rmld + rmc0 + col);
    if (CM == C_BRB) { const u32x4 y = *(const GAS u32x4*)dst;
      v[0] += lo_f(y[0]); v[1] += hi_f(y[0]); v[2] += lo_f(y[1]); v[3] += hi_f(y[1]); v[4] += lo_f(y[2]); v[5] += hi_f(y[2]); v[6] += lo_f(y[3]); v[7] += hi_f(y[3]); }
    if (CM != C_MLA || dst) { u32x4 o = {pk2(v[0], v[1]), pk2(v[2], v[3]), pk2(v[4], v[5]), pk2(v[6], v[7])}; if (!nostore) { if (CM == C_BRA) *(GAS u32x4*)dst = o; else __builtin_nontemporal_store(o, (GAS u32x4*)dst); } else asm volatile("" :: "v"(o)); }
  }
}

DI void gemm_tile(const int tx, const int wv_s, bf16_t* shm, unsigned char* ws, const GemmJob& J, int pm, int pn, const bool skip_epi) {
  const bf16_t* __restrict__ A = J.A; const bf16_t* __restrict__ Bt = J.Bt;
  const int lda = J.lda, K = J.K;
#define SA(b, h) (shm + ((b) * 2 + (h)) * HT)
#define SB(b, h) (shm + (4 + (b) * 2 + (h)) * HT)
#define STAGE(P, BASE, OFFS, LD, br, kt) do { const char* _base = (const char*)((BASE) + ((long)(br) * (LD) + (long)(kt) * BK)); \
    _Pragma("unroll") for (int _i = 0; _i < 2; ++_i) { \
      __builtin_amdgcn_global_load_lds((const unsigned*)(_base + (unsigned long)OFFS[_i]), \
        (__attribute__((address_space(3))) unsigned*)((char*)(P) + wv_s * 1024 + _i * 8192), 16, 0, 0); } } while (0)
#define LDA(dst, b, h) _Pragma("unroll") for (int m = 0; m < 4; ++m) _Pragma("unroll") for (int k = 0; k < 2; ++k) \
    dst[m][k] = *(const __attribute__((address_space(3))) bf16x8*)(pA + (((b) * 2 + (h)) * 16384 + (m * 2 + k) * 1024))
#define LDB(dst, b, h) _Pragma("unroll") for (int n = 0; n < 2; ++n) _Pragma("unroll") for (int k = 0; k < 2; ++k) \
    dst[n][k] = *(const __attribute__((address_space(3))) bf16x8*)(pB + (((b) * 2 + (h)) * 16384 + (n * 2 + k) * 1024))
#define MMA(ai, bj, At, Bf) do { __builtin_amdgcn_s_setprio(1); \
    _Pragma("unroll") for (int m = 0; m < 4; ++m) _Pragma("unroll") for (int n = 0; n < 2; ++n) _Pragma("unroll") for (int k = 0; k < 2; ++k) \
      acc[ai][bj][m][n] = __builtin_amdgcn_mfma_f32_16x16x32_bf16(Bf[n][k], At[m][k], acc[ai][bj][m][n], 0, 0, 0); \
    __builtin_amdgcn_s_setprio(0); } while (0)
#define WAIT_V(n) asm volatile("s_waitcnt vmcnt(" #n ")" ::: "memory")
#define WAIT_L(n) asm volatile("s_waitcnt lgkmcnt(" #n ")" ::: "memory")
#define BAR __builtin_amdgcn_s_barrier()
#define SCHED __builtin_amdgcn_sched_barrier(0)
  const int brow = pm * BM, bcol = pn * BM;
  const int wid = tx >> 6, lane = tx & 63, wr = wid >> 2, wc = wid & 3, fr = lane & 15, fq = lane >> 4;
  f32x4 acc[2][2][4][2] = {};
  bf16x8 At[4][2], B0[2][2], B1[2][2];
  const int nt = K / BK;
  unsigned offA[2], offB[2];
  _Pragma("unroll") for (int _i = 0; _i < 2; ++_i) { int _r, _c; stage_rc(tx * 16 + _i * 8192, _r, _c); offA[_i] = (unsigned)(_r * lda + _c) * 2u; offB[_i] = (unsigned)(_r * K + _c) * 2u; }
  const int lbx = (fr * 64 + fq * 16) ^ ((fr >> 3) << 5);
  const __attribute__((address_space(3))) unsigned char* pA = (const __attribute__((address_space(3))) unsigned char*)shm + (wr * 8192 + lbx);
  const __attribute__((address_space(3))) unsigned char* pB = (const __attribute__((address_space(3))) unsigned char*)shm + (65536 + wc * 4096 + lbx);
  STAGE(SB(0, 0), Bt, offB, K, bcol, 0); STAGE(SA(0, 0), A, offA, lda, brow, 0);
  STAGE(SB(0, 1), Bt, offB, K, bcol + HALF, 0); STAGE(SA(0, 1), A, offA, lda, brow + HALF, 0);
  if (wr == 1) BAR;
  WAIT_V(4); BAR;
  STAGE(SB(1, 0), Bt, offB, K, bcol, 1); STAGE(SA(1, 0), A, offA, lda, brow, 1); STAGE(SB(1, 1), Bt, offB, K, bcol + HALF, 1);
  WAIT_V(6); BAR;
  for (int t = 0; t < nt - 2; t += 2) {
    LDB(B0, 0, 0); SCHED; LDA(At, 0, 0); STAGE(SA(1, 1), A, offA, lda, brow + HALF, t + 1);
    WAIT_L(8); BAR; WAIT_L(0); MMA(0, 0, At, B0); BAR; SCHED;
    LDB(B1, 0, 1); STAGE(SB(0, 0), Bt, offB, K, bcol, t + 2);
    BAR; WAIT_L(0); MMA(0, 1, At, B1); BAR;
    LDA(At, 0, 1); STAGE(SA(0, 0), A, offA, lda, brow, t + 2);
    BAR; WAIT_L(0); MMA(1, 0, At, B0); BAR; SCHED;
    STAGE(SB(0, 1), Bt, offB, K, bcol + HALF, t + 2);
    WAIT_V(6); BAR; MMA(1, 1, At, B1); BAR;
    LDB(B0, 1, 0); SCHED; LDA(At, 1, 0); STAGE(SA(0, 1), A, offA, lda, brow + HALF, t + 2);
    WAIT_L(8); BAR; WAIT_L(0); MMA(0, 0, At, B0); BAR; SCHED;
    LDB(B1, 1, 1); STAGE(SB(1, 0), Bt, offB, K, bcol, t + 3);
    BAR; WAIT_L(0); MMA(0, 1, At, B1); BAR;
    LDA(At, 1, 1); STAGE(SA(1, 0), A, offA, lda, brow, t + 3);
    BAR; WAIT_L(0); MMA(1, 0, At, B0); BAR; SCHED;
    STAGE(SB(1, 1), Bt, offB, K, bcol + HALF, t + 3);
    WAIT_V(6); BAR; MMA(1, 1, At, B1); BAR;
  }
  { LDB(B0, 0, 0); LDA(At, 0, 0); STAGE(SA(1, 1), A, offA, lda, brow + HALF, nt - 1);
    BAR; WAIT_L(0); MMA(0, 0, At, B0); BAR;
    LDB(B1, 0, 1); BAR; WAIT_L(0); MMA(0, 1, At, B1); BAR;
    LDA(At, 0, 1); WAIT_V(4); BAR; WAIT_L(0); MMA(1, 0, At, B0); MMA(1, 1, At, B1); BAR; }
  { LDB(B0, 1, 0); LDA(At, 1, 0); WAIT_V(2); BAR; WAIT_L(0); MMA(0, 0, At, B0); BAR;
    LDB(B1, 1, 1); WAIT_V(0); BAR; WAIT_L(0); MMA(0, 1, At, B1); BAR;
    LDA(At, 1, 1); BAR; WAIT_L(0); MMA(1, 0, At, B0); MMA(1, 1, At, B1); BAR; }
  if (wr == 0) BAR;
#undef SA
#undef SB
#undef STAGE
#undef LDA
#undef LDB
#undef MMA
  const int mode = J.mode;
  const int grp = pn >> 3;
  unsigned char* T0 = (unsigned char*)shm;
  const int tid = wv_s * 64 + lane_id_v();
  const int wid_e = tid >> 6, lane_e = tid & 63, wr_e = wid_e >> 2, wc_e = wid_e & 3, fr_e = lane_e & 15, fq_e = lane_e >> 4;
  const bool trall = (mode == M_WIN && grp == 2) || (mode == M_XAKV && pn >= 2);
  const int ncol_rm = trall ? 0 : ((mode == M_SWIGLU || mode == M_KVUP) ? 128 : 256);
  const int tr_c0 = trall ? 0 : 128, tr_nc = trall ? 256 : (mode == M_KVUP ? 128 : 0);
  bf16_t* rmb = J.o0; long rmld = J.ldc; int rmc0 = bcol;
  bf16_t* trb = nullptr; long trs = 0;
  if (mode == M_SWIGLU) rmc0 = pn * 128;
  else if (mode == M_KVUP) { rmc0 = pn * 128; trb = (bf16_t*)(ws + R_VT) + ((long)((brow >> 11) * 16 + pn) * 128 - 128) * 2048 + (brow & 2047); trs = 2048; }
  else if (mode == M_XAKV) { trb = (bf16_t*)(ws + OFF_XAVT) + ((long)((brow >> 8) * 4 + (pn - 2) * 2) * 128) * 256; trs = 256; }
  else if (mode == M_WIN) {
    if (grp == 1) { rmb = (bf16_t*)(ws + R_KK); rmc0 = bcol - 2048; }
    else if (grp == 2) { trb = (bf16_t*)(ws + R_IT) + ((long)(brow >> 11) * 2048 + (bcol - 4096)) * 2048 + (brow & 2047); trs = 2048; }
    else if (grp == 3) { rmb = (bf16_t*)(ws + R_SOG); rmc0 = bcol - 6144; }
  }
  const bool mla = (mode == M_WIN && grp >= 4);
  const int sh = (ncol_rm == 128) ? 4 : 5;
  _Pragma("unroll") for (int ai = 0; ai < 2; ++ai) {
    _Pragma("unroll") for (int bj = 0; bj < 2; ++bj) _Pragma("unroll") for (int m = 0; m < 4; ++m) _Pragma("unroll") for (int n = 0; n < 2; ++n) {
      const int row = wr_e * 64 + m * 16 + fr_e, col = bj * 128 + wc_e * 32 + n * 16 + fq_e * 4;
      *(f32x4*)(T0 + row * 1024 + (((col >> 2) ^ (row & 15)) << 4)) = acc[ai][bj][m][n];
    }
    asm volatile("s_waitcnt lgkmcnt(0)" ::: "memory"); __builtin_amdgcn_s_barrier();
    if (!trall) {
      const int g0 = brow + ai * 128, ld32 = (int)rmld;
      if (mode == M_SWIGLU) copy_rm<C_SWIGLU, 4>(T0, tid, ws, rmb, ld32, rmc0, g0, bcol, skip_epi);
      else if (mode == M_STORE || mode == M_XAKV) copy_rm<C_STORE, 5>(T0, tid, ws, rmb, ld32, rmc0, g0, bcol, skip_epi);
      else if (mode == M_KVUP) copy_rm<C_STORE, 4>(T0, tid, ws, rmb, ld32, rmc0, g0, bcol, skip_epi);
      else if (mode == M_SIGMOID) copy_rm<C_SIGMOID, 5>(T0, tid, ws, rmb, ld32, rmc0, g0, bcol, skip_epi);
      else if (mode == M_BRA) copy_rm<C_BRA, 5>(T0, tid, ws, rmb, ld32, rmc0, g0, bcol, skip_epi);
      else if (mode == M_BRB) copy_rm<C_BRB, 5>(T0, tid, ws, rmb, ld32, rmc0, g0, bcol, skip_epi);
      else if (grp == 1) copy_rm<C_KK, 5>(T0, tid, ws, rmb, ld32, rmc0, g0, bcol, skip_epi);
      else if (grp >= 4) copy_rm<C_MLA, 5>(T0, tid, ws, rmb, ld32, rmc0, g0, bcol, skip_epi);
      else copy_rm<C_SILU, 5>(T0, tid, ws, rmb, ld32, rmc0, g0, bcol, skip_epi);
    }
    const int ntr = tr_nc * 16;
    for (int it = tid; it < ntr; it += 512) {
      const int colr = (it >> 7) * 8 + (it & 7), rc = (it >> 3) & 15, col = tr_c0 + colr;
      float v[8];
      _Pragma("unroll") for (int k = 0; k < 8; ++k) { const int row = rc * 8 + k;
        v[k] = *(const float*)(T0 + row * 1024 + ((((col >> 2)) ^ (row & 15)) << 4) + (col & 3) * 4); }
      uint4 o; o.x = pk2(v[0], v[1]); o.y = pk2(v[2], v[3]); o.z = pk2(v[4], v[5]); o.w = pk2(v[6], v[7]);
      { u32x4 ov_ = {o.x, o.y, o.z, o.w}; *(GAS u32x4*)(trb + (long)col * trs + ai * 128 + rc * 8) = ov_; }
    }
    asm volatile("s_waitcnt lgkmcnt(0)" ::: "memory"); __builtin_amdgcn_s_barrier();
  }
}

enum { RM_ID = 0, RM_GATE, RM_UP, RM_WIN };
__device__ __noinline__ void transpose_job(const int tx, float* tile_base, const float* __restrict__ W, int K, int N, bf16_t* dst, int rm, int start, int stride) {
  const int lane = tx & 63, wave = tx >> 6;
  unsigned char* L = (unsigned char*)tile_base + wave * 4608;
  const int tk = K >> 6, tn = N >> 5, nt = tk * tn;
  const int lr = lane >> 3, lc = (lane & 7) * 4;
  for (int t = start * 8 + wave; t < nt; t += stride * 8) {
    const int kt = t % tk, ntile = t / tk, k0 = kt * 64, n0 = ntile * 32;
    f32x4 v[8];
    const float* src = W + (long)(k0 + lr * 2) * N + n0 + lc;
    _Pragma("unroll") for (int i = 0; i < 4; ++i) { v[2 * i] = __builtin_nontemporal_load((const f32x4*)(src + (long)(i * 16) * N)); v[2 * i + 1] = __builtin_nontemporal_load((const f32x4*)(src + (long)(i * 16 + 1) * N)); }
    _Pragma("unroll") for (int i = 0; i < 4; ++i) _Pragma("unroll") for (int j = 0; j < 4; ++j)
      *(unsigned*)(L + (lc + j) * 144 + (i * 16 + lr * 2) * 2) = pk2(v[2 * i][j], v[2 * i + 1][j]);
    asm volatile("s_waitcnt lgkmcnt(0)" ::: "memory");
    _Pragma("unroll") for (int q = 0; q < 4; ++q) {
      const int c = lane + 64 * q, n = c >> 3, kc = c & 7;
      const uint4 val = *(const uint4*)(L + n * 144 + kc * 16);
      const int nn = n0 + n; int drow;
      if (rm == RM_ID) drow = nn; else if (rm == RM_GATE) drow = (nn >> 7) * 256 + (nn & 127);
      else if (rm == RM_UP) drow = (nn >> 7) * 256 + 128 + (nn & 127); else drow = nn < 9280 ? nn : nn + 192;
      *(uint4*)(dst + (long)drow * K + k0 + kc * 8) = val;
    }
    asm volatile("s_waitcnt lgkmcnt(0)" ::: "memory");
  }
}

__device__ __noinline__ void norm_rows(const int tx, const int blk, const int nblk, int nrows, const float* res, const bf16_t* y, const float* pg, float w, float* xout, const float* ng, bf16_t* hout) {
  const int lane = tx & 63;
  const int gw = blk * 8 + (tx >> 6), nw = nblk * 8;
  for (int row = gw; row < nrows; row += nw) {
    f32x4 xv[8];
    const float* rp = res + (long)row * 2048;
    _Pragma("unroll") for (int i = 0; i < 8; ++i) xv[i] = __builtin_nontemporal_load((const f32x4*)(rp + i * 256 + lane * 4));
    if (y) {
      f32x4 yv[8]; float ss = 0.f;
      const bf16_t* yp = y + (long)row * 2048;
      _Pragma("unroll") for (int i = 0; i < 8; ++i) { typedef unsigned u32x2_t __attribute__((ext_vector_type(2))); const u32x2_t u_ = __builtin_nontemporal_load((const u32x2_t*)(yp + i * 256 + lane * 4)); uint2 u; u.x = u_[0]; u.y = u_[1];
        yv[i][0] = lo_f(u.x); yv[i][1] = hi_f(u.x); yv[i][2] = lo_f(u.y); yv[i][3] = hi_f(u.y);
        _Pragma("unroll") for (int j = 0; j < 4; ++j) ss += yv[i][j] * yv[i][j]; }
      ss = wave_sum(ss);
      const float rs = rsqrtf(ss * (1.f / 2048.f) + EPS) * w;
      _Pragma("unroll") for (int i = 0; i < 8; ++i) { f32x4 g = *(const f32x4*)(pg + i * 256 + lane * 4);
        _Pragma("unroll") for (int j = 0; j < 4; ++j) xv[i][j] += yv[i][j] * rs * g[j]; }
    }
    if (xout) { float* op = xout + (long)row * 2048; _Pragma("unroll") for (int i = 0; i < 8; ++i) __builtin_nontemporal_store(xv[i], (f32x4*)(op + i * 256 + lane * 4)); }
    if (hout) {
      float ss = 0.f; _Pragma("unroll") for (int i = 0; i < 8; ++i) _Pragma("unroll") for (int j = 0; j < 4; ++j) ss += xv[i][j] * xv[i][j];
      ss = wave_sum(ss);
      const float rs = rsqrtf(ss * (1.f / 2048.f) + EPS);
      bf16_t* hp = hout + (long)row * 2048;
      _Pragma("unroll") for (int i = 0; i < 8; ++i) { f32x4 g = *(const f32x4*)(ng + i * 256 + lane * 4); f32x4 r;
        _Pragma("unroll") for (int j = 0; j < 4; ++j) r[j] = xv[i][j] * rs * g[j];
        store4(hp + i * 256 + lane * 4, r); }
    }
  }
}

__device__ __noinline__ void mla_prep(const int tx, bf16_t* cq, bf16_t* ckv, bf16_t* kpe, const float* qg, const float* kvg, const float* cosT, const float* sinT, int start_w, int n_w) {
  const int lane = tx & 63;
  for (int row = start_w; row < T_TOK; row += n_w) {
    _Pragma("unroll") for (int which = 0; which < 2; ++which) {
      bf16_t* p = (which ? ckv : cq) + (long)row * 512 + lane * 8; const float* g = (which ? kvg : qg) + lane * 8;
      uint4 u = *(const uint4*)p; float v[8] = {lo_f(u.x), hi_f(u.x), lo_f(u.y), hi_f(u.y), lo_f(u.z), hi_f(u.z), lo_f(u.w), hi_f(u.w)};
      float ss = 0.f; _Pragma("unroll") for (int j = 0; j < 8; ++j) ss += v[j] * v[j];
      ss = wave_sum(ss); const float rs = rsqrtf(ss * (1.f / 512.f) + EPS);
      _Pragma("unroll") for (int j = 0; j < 8; ++j) v[j] = v[j] * rs * g[j];
      u.x = pk2(v[0], v[1]); u.y = pk2(v[2], v[3]); u.z = pk2(v[4], v[5]); u.w = pk2(v[6], v[7]);
      *(uint4*)p = u;
    }
    const int i = lane & 31;
    const float x1 = bf2f(kpe[(long)row * 64 + i]), x2 = bf2f(kpe[(long)row * 64 + 32 + i]);
    const float c = cosT[(long)row * 32 + i], s = sinT[(long)row * 32 + i];
    const float r = (lane < 32) ? (x1 * c - x2 * s) : (x2 * c + x1 * s);
    kpe[(long)row * 64 + lane] = f2bf(r);
  }
}

struct AttnArgs {
  const bf16_t* Q; int ldq; const bf16_t* Kn; int ldk; const bf16_t* Kpe; const bf16_t* VT; bf16_t* O; int ldo;
  const float* cosT; const float* sinT; int H, Sq, Sk; float c;
};
#define MFMA32(a, b, c) __builtin_amdgcn_mfma_f32_32x32x16_bf16((a), (b), (c), 0, 0, 0)

template <int DQK, bool CAUSAL>
DI void attn_unit(const int tx, unsigned char* smem, const AttnArgs& a, int b, int h, int qt) {
  constexpr int KSTR = (DQK + 8) * 2;
  constexpr int VSTR = 68 * 2;
  constexpr int KBUF = 64 * KSTR, VBUF = 128 * VSTR;
  constexpr int NKS = DQK / 16;
  constexpr int KCH = DQK / 8;
  constexpr int NKL = 64 * KCH / 512;
  unsigned char* Ks = smem; unsigned char* Vs = smem + 2 * KBUF;
  const int tid = tx, lane = tid & 63, wave = tid >> 6, r = lane & 31, hh = lane >> 5;
  const long qrow = (long)b * a.Sq + qt * 256 + wave * 32 + r;
  const int xaddr = (lane ^ 32) << 2;
  bf16x8 qf[NKS];
  { const bf16_t* qp = a.Q + qrow * a.ldq + h * DQK + 8 * hh;
    _Pragma("unroll") for (int ks = 0; ks < NKS; ++ks) qf[ks] = *(const bf16x8*)(qp + ks * 16); }
  if (DQK == 192) {
    _Pragma("unroll") for (int ks = 8; ks < 10; ++ks) {
      const int i0 = 16 * (ks - 8) + 8 * hh;
      float cs[8], sn[8];
      { f32x4 c0 = *(const f32x4*)(a.cosT + qrow * 32 + i0), c1 = *(const f32x4*)(a.cosT + qrow * 32 + i0 + 4);
        f32x4 s0 = *(const f32x4*)(a.sinT + qrow * 32 + i0), s1 = *(const f32x4*)(a.sinT + qrow * 32 + i0 + 4);
        _Pragma("unroll") for (int j = 0; j < 4; ++j) { cs[j] = c0[j]; cs[4 + j] = c1[j]; sn[j] = s0[j]; sn[4 + j] = s1[j]; } }
      bf16x8 x1 = qf[ks], x2 = qf[ks + 2], y1, y2;
      _Pragma("unroll") for (int j = 0; j < 8; j += 2) {
        float a0 = bf2f((bf16_t)x1[j]), a1 = bf2f((bf16_t)x1[j + 1]), b0 = bf2f((bf16_t)x2[j]), b1 = bf2f((bf16_t)x2[j + 1]);
        unsigned u1 = pk2(a0 * cs[j] - b0 * sn[j], a1 * cs[j + 1] - b1 * sn[j + 1]);
        unsigned u2 = pk2(b0 * cs[j] + a0 * sn[j], b1 * cs[j + 1] + a1 * sn[j + 1]);
        y1[j] = (short)(u1 & 0xffff); y1[j + 1] = (short)(u1 >> 16); y2[j] = (short)(u2 & 0xffff); y2[j + 1] = (short)(u2 >> 16);
      }
      qf[ks] = y1; qf[ks + 2] = y2;
    }
  }
  const int nkt = CAUSAL ? 4 * (qt + 1) : a.Sk / 64;
  const int kmax = CAUSAL ? 4 * qt + (wave >> 1) : nkt - 1;
  uint4 kr0, kr1, kr2, vr0, vr1;
  kr2 = uint4{0, 0, 0, 0};
  const long krow0 = (long)b * a.Sk;
  const bf16_t* vtb = a.VT + ((long)(b * a.H + h) * 128) * a.Sk;
#define KSRC(i, kt) ({ const int c_ = tid + 512 * (i), row_ = c_ / KCH, cc_ = c_ % KCH; const long tok_ = krow0 + (kt) * 64 + row_; \
    (cc_ < 16) ? (a.Kn + tok_ * a.ldk + h * 128 + cc_ * 8) : (a.Kpe + tok_ * 64 + (cc_ - 16) * 8); })
#define KDST(i, buf) (Ks + (buf) * KBUF + ((tid + 512 * (i)) / KCH) * KSTR + ((tid + 512 * (i)) % KCH) * 16)
#define VSRC(i, kt) (vtb + (long)((tid + 512 * (i)) >> 3) * a.Sk + (kt) * 64 + ((tid + 512 * (i)) & 7) * 8)
#define VDST(i, buf) (Vs + (buf) * VBUF + ((tid + 512 * (i)) >> 3) * VSTR + ((tid + 512 * (i)) & 7) * 16)
#define GLOAD(kt) do { kr0 = *(const uint4*)KSRC(0, kt); kr1 = *(const uint4*)KSRC(1, kt); if (NKL > 2) kr2 = *(const uint4*)KSRC(2, kt); \
    vr0 = *(const uint4*)VSRC(0, kt); vr1 = *(const uint4*)VSRC(1, kt); } while (0)
#define LSTORE(buf) do { *(uint4*)KDST(0, buf) = kr0; *(uint4*)KDST(1, buf) = kr1; if (NKL > 2) *(uint4*)KDST(2, buf) = kr2; \
    *(uint2*)VDST(0, buf) = uint2{vr0.x, vr0.y}; *(uint2*)(VDST(0, buf) + 8) = uint2{vr0.z, vr0.w}; *(uint2*)VDST(1, buf) = uint2{vr1.x, vr1.y}; *(uint2*)(VDST(1, buf) + 8) = uint2{vr1.z, vr1.w}; } while (0)
  f32x16 o[4];
  _Pragma("unroll") for (int mt = 0; mt < 4; ++mt) _Pragma("unroll") for (int i = 0; i < 16; ++i) o[mt][i] = 0.f;
  float m_run = -INFINITY, l_run = 0.f;
  __syncthreads();
  GLOAD(0); LSTORE(0);
  __syncthreads();
  for (int kt = 0; kt < nkt; ++kt) {
    const int buf = kt & 1;
    if (kt + 1 < nkt) GLOAD(kt + 1);
    if (kt <= kmax) {
      f32x16 s0, s1;
      _Pragma("unroll") for (int i = 0; i < 16; ++i) { s0[i] = 0.f; s1[i] = 0.f; }
      const unsigned char* kb = Ks + buf * KBUF + r * KSTR + 16 * hh;
      _Pragma("unroll") for (int kg = 0; kg < NKS; kg += 4) {
        bf16x8 ka0[4], ka1[4];
        _Pragma("unroll") for (int u = 0; u < 4; ++u) { ka0[u] = *(const bf16x8*)(kb + (kg + u) * 32); ka1[u] = *(const bf16x8*)(kb + 32 * KSTR + (kg + u) * 32); }
        _Pragma("unroll") for (int u = 0; u < 4; ++u) { s0 = MFMA32(ka0[u], qf[kg + u], s0); s1 = MFMA32(ka1[u], qf[kg + u], s1); }
      }
      float mx = s0[0];
      _Pragma("unroll") for (int i = 1; i < 16; ++i) mx = fmaxf(mx, s0[i]);
      _Pragma("unroll") for (int i = 0; i < 16; ++i) mx = fmaxf(mx, s1[i]);
      mx = fmaxf(mx, __int_as_float(__builtin_amdgcn_ds_bpermute(xaddr, __float_as_int(mx))));
      const float m_new = fmaxf(m_run, mx);
      const float alpha = __builtin_amdgcn_exp2f((m_run - m_new) * a.c);
      m_run = m_new;
      float ls = 0.f; const float mc = m_new * a.c;
      _Pragma("unroll") for (int i = 0; i < 16; ++i) { s0[i] = __builtin_amdgcn_exp2f(s0[i] * a.c - mc); ls += s0[i]; }
      _Pragma("unroll") for (int i = 0; i < 16; ++i) { s1[i] = __builtin_amdgcn_exp2f(s1[i] * a.c - mc); ls += s1[i]; }
      l_run = l_run * alpha + ls;
      if (__builtin_amdgcn_ballot_w64(alpha != 1.f) != 0ull) { _Pragma("unroll") for (int mt = 0; mt < 4; ++mt) _Pragma("unroll") for (int i = 0; i < 16; ++i) o[mt][i] *= alpha; }
      bf16x8 pf[4];
      _Pragma("unroll") for (int s = 0; s < 4; ++s) {
        unsigned u[4];
        _Pragma("unroll") for (int j = 0; j < 4; ++j) { const int ri = 8 * (s & 1) + 2 * j;
          u[j] = (s < 2) ? pk2(s0[ri], s0[ri + 1]) : pk2(s1[ri], s1[ri + 1]); }
        uint4 uu = {u[0], u[1], u[2], u[3]}; pf[s] = __builtin_bit_cast(bf16x8, uu);
      }
      const unsigned char* vb = Vs + buf * VBUF + r * VSTR + 8 * hh;
      _Pragma("unroll") for (int mt = 0; mt < 4; ++mt) {
        s16x4 lo[4], hi[4];
        _Pragma("unroll") for (int s = 0; s < 4; ++s) { lo[s] = *(const s16x4*)(vb + mt * 32 * VSTR + s * 32); hi[s] = *(const s16x4*)(vb + mt * 32 * VSTR + s * 32 + 16); }
        _Pragma("unroll") for (int s = 0; s < 4; ++s) {
          bf16x8 av = __builtin_shufflevector(lo[s], hi[s], 0, 1, 2, 3, 4, 5, 6, 7);
          o[mt] = MFMA32(av, pf[s], o[mt]);
        }
      }
    }
    if (kt + 1 < nkt) LSTORE(buf ^ 1);
    __syncthreads();
  }
  const float lt = l_run + __int_as_float(__builtin_amdgcn_ds_bpermute(xaddr, __float_as_int(l_run)));
  const float inv = 1.f / lt;
  bf16_t* op = a.O + qrow * a.ldo + h * 128 + 4 * hh;
  _Pragma("unroll") for (int mt = 0; mt < 4; ++mt) _Pragma("unroll") for (int g = 0; g < 4; ++g) {
    f32x4 v = {o[mt][4 * g] * inv, o[mt][4 * g + 1] * inv, o[mt][4 * g + 2] * inv, o[mt][4 * g + 3] * inv};
    store4(op + mt * 32 + 8 * g, v);
  }
}

#undef KSRC
#undef KDST
#undef VSRC
#undef VDST
#undef GLOAD
#undef LSTORE
#define MFMA16(a, b, c) __builtin_amdgcn_mfma_f32_16x16x32_bf16((a), (b), (c), 0, 0, 0)
DI void hgrn_unit(const int tx, unsigned char* smem, const bf16_t* qs, const bf16_t* kk, const bf16_t* iT, const bf16_t* sog, const float* hgg, bf16_t* oa, int b, int h) {
  constexpr int QSTR = 136 * 2, SSTR = 72 * 2, OSTR = 132 * 4;
  unsigned char* QH = smem;
  unsigned char* KH = smem + 17408;
  unsigned char* KHT = smem + 34816;
  unsigned char* VT = smem + 53248;
  unsigned char* PS = smem + 71680;
  unsigned char* ST = smem + 80896;
  float* BT = (float*)(smem + 115712);
  unsigned char* OF = smem + 17408;
  const int tid = tx, lane = tid & 63, w = tid >> 6, fr = lane & 15, fq = lane >> 4;
  const int kcol = tid & 127, sb = tid >> 7;
  f32x4 S[8];
  _Pragma("unroll") for (int i = 0; i < 8; ++i) S[i] = f32x4{0.f, 0.f, 0.f, 0.f};
  __syncthreads();
  unsigned short pk_[16], pq_[16]; uint4 pv0, pv1;
#define HG_LOAD(nn) do { const long t0_ = (long)b * 2048 + (nn) * 64; \
    const bf16_t* kp_ = kk + (t0_ + sb * 16) * 2048 + h * 128 + kcol; const bf16_t* qp_ = qs + (t0_ + sb * 16) * 2048 + h * 128 + kcol; \
    _Pragma("unroll") for (int i = 0; i < 16; ++i) { pk_[i] = kp_[(long)i * 2048]; pq_[i] = qp_[(long)i * 2048]; } \
    pv0 = *(const uint4*)(iT + ((long)(b * 16 + h) * 128 + (tid >> 3)) * 2048 + (nn) * 64 + (tid & 7) * 8); \
    pv1 = *(const uint4*)(iT + ((long)(b * 16 + h) * 128 + 64 + (tid >> 3)) * 2048 + (nn) * 64 + (tid & 7) * 8); } while (0)
  HG_LOAD(0);
  float hgw[16];
  { const int part_ = tid & 7; _Pragma("unroll") for (int i = 0; i < 16; ++i) hgw[i] = hgg[h * 128 + part_ * 16 + i]; }
  _Pragma("unroll 1") for (int n = 0; n < 32; ++n) {
    const long tok0 = (long)b * 2048 + n * 64;
    float cq[16], ck[16], cb[16];
    { float run = 0.f;
      _Pragma("unroll") for (int i = 0; i < 16; ++i) { ck[i] = fminf(fmaxf(bf2f(pk_[i]), 0.f), 0.999f); cq[i] = bf2f(pq_[i]);
        run += flog_(1.f - ck[i]); cb[i] = run; }
      BT[sb * 128 + kcol] = run; }
    *(uint4*)(VT + (tid >> 3) * SSTR + (tid & 7) * 16) = pv0; *(uint4*)(VT + (64 + (tid >> 3)) * SSTR + (tid & 7) * 16) = pv1;
    if (n + 1 < 32) HG_LOAD(n + 1);
    const long sog_off = (tok0 + (tid >> 3)) * 2048 + h * 128 + (tid & 7) * 16;
    const uint4 g0 = *(const uint4*)(sog + sog_off), g1 = *(const uint4*)(sog + sog_off + 8);
    __syncthreads();
    { float pre = 0.f; _Pragma("unroll") for (int j = 0; j < 4; ++j) if (j < sb) pre += BT[j * 128 + kcol];
      const float b31 = BT[kcol] + BT[128 + kcol];
      unsigned kt[8];
      _Pragma("unroll") for (int i = 0; i < 16; i += 2) {
        const float d0 = fminf(fmaxf(pre + cb[i] - b31, -80.f), 80.f), d1 = fminf(fmaxf(pre + cb[i + 1] - b31, -80.f), 80.f);
        const float q0 = cq[i] * fexp_(d0), q1 = cq[i + 1] * fexp_(d1);
        const float k0 = ck[i] * fexp_(-d0), k1 = ck[i + 1] * fexp_(-d1);
        *(bf16_t*)(QH + (sb * 16 + i) * QSTR + kcol * 2) = f2bf(q0); *(bf16_t*)(QH + (sb * 16 + i + 1) * QSTR + kcol * 2) = f2bf(q1);
        const unsigned kp2 = pk2(k0, k1);
        *(bf16_t*)(KH + (sb * 16 + i) * QSTR + kcol * 2) = (bf16_t)(kp2 & 0xffff); *(bf16_t*)(KH + (sb * 16 + i + 1) * QSTR + kcol * 2) = (bf16_t)(kp2 >> 16);
        kt[i >> 1] = kp2;
      }
      *(uint4*)(KHT + kcol * SSTR + sb * 32) = uint4{kt[0], kt[1], kt[2], kt[3]};
      *(uint4*)(KHT + kcol * SSTR + sb * 32 + 16) = uint4{kt[4], kt[5], kt[6], kt[7]};
      float e31[4];
      _Pragma("unroll") for (int j = 0; j < 4; ++j) { const int k = w * 16 + fq * 4 + j; e31[j] = fexp_(BT[k] + BT[128 + k]); }
      _Pragma("unroll") for (int vt = 0; vt < 8; ++vt) { _Pragma("unroll") for (int j = 0; j < 4; ++j) S[vt][j] *= e31[j];
        store4((bf16_t*)(ST + (vt * 16 + fr) * QSTR + (w * 16 + fq * 4) * 2), S[vt]); }
    }
    __syncthreads();
    _Pragma("unroll") for (int tt = 0; tt < 2; ++tt) {
      const int tile = 2 * w + tt, ti = tile >> 2, si = tile & 3;
      f32x4 acc = {0.f, 0.f, 0.f, 0.f};
      if (si <= ti) {
        _Pragma("unroll") for (int st = 0; st < 4; ++st) {
          bf16x8 af = *(const bf16x8*)(KH + (si * 16 + fr) * QSTR + st * 64 + fq * 16);
          bf16x8 bfr = *(const bf16x8*)(QH + (ti * 16 + fr) * QSTR + st * 64 + fq * 16);
          acc = MFMA16(af, bfr, acc);
        }
        const int t = ti * 16 + fr;
        _Pragma("unroll") for (int j = 0; j < 4; ++j) { const int s = si * 16 + fq * 4 + j; if (s > t) acc[j] = 0.f; }
      }
      store4((bf16_t*)(PS + (ti * 16 + fr) * SSTR + (si * 16 + fq * 4) * 2), acc);
    }
    { float e63[4];
      _Pragma("unroll") for (int j = 0; j < 4; ++j) { const int k = w * 16 + fq * 4 + j; e63[j] = fexp_(BT[256 + k] + BT[384 + k]); }
      _Pragma("unroll") for (int vt = 0; vt < 8; ++vt) {
        f32x4 acc = S[vt];
        _Pragma("unroll") for (int st = 0; st < 2; ++st) {
          bf16x8 af = *(const bf16x8*)(KHT + (w * 16 + fr) * SSTR + st * 64 + fq * 16);
          bf16x8 bfr = *(const bf16x8*)(VT + (vt * 16 + fr) * SSTR + st * 64 + fq * 16);
          acc = MFMA16(af, bfr, acc);
        }
        _Pragma("unroll") for (int j = 0; j < 4; ++j) S[vt][j] = acc[j] * e63[j];
      } }
    __syncthreads();
    f32x4 oacc[4];
    _Pragma("unroll") for (int tt = 0; tt < 4; ++tt) {
      f32x4 acc = {0.f, 0.f, 0.f, 0.f};
      _Pragma("unroll") for (int st = 0; st < 2; ++st) {
        bf16x8 af = *(const bf16x8*)(VT + (w * 16 + fr) * SSTR + st * 64 + fq * 16);
        bf16x8 bfr = *(const bf16x8*)(PS + (tt * 16 + fr) * SSTR + st * 64 + fq * 16);
        acc = MFMA16(af, bfr, acc);
      }
      _Pragma("unroll") for (int st = 0; st < PROBE_ST; ++st) {
        bf16x8 af = *(const bf16x8*)(ST + (w * 16 + fr) * QSTR + st * 64 + fq * 16);
        bf16x8 bfr = *(const bf16x8*)(QH + (tt * 16 + fr) * QSTR + st * 64 + fq * 16);
        acc = MFMA16(af, bfr, acc);
      }
      oacc[tt] = acc;
    }
    _Pragma("unroll") for (int tt = 0; tt < 4; ++tt) *(f32x4*)(OF + (tt * 16 + fr) * OSTR + (w * 16 + fq * 4) * 4) = oacc[tt];
    __syncthreads();
    { const int t = tid >> 3, part = tid & 7;
      float ov[16]; float ss = 0.f;
      _Pragma("unroll") for (int i = 0; i < 4; ++i) { f32x4 v = *(const f32x4*)(OF + t * OSTR + (part * 16 + i * 4) * 4);
        _Pragma("unroll") for (int j = 0; j < 4; ++j) { ov[i * 4 + j] = v[j]; ss += v[j] * v[j]; } }
      ss += __int_as_float(__builtin_amdgcn_ds_swizzle(__float_as_int(ss), 0x041f)); ss += __int_as_float(__builtin_amdgcn_ds_swizzle(__float_as_int(ss), 0x081f)); ss += __int_as_float(__builtin_amdgcn_ds_swizzle(__float_as_int(ss), 0x101f));
      const float rs = rsqrtf(ss * (1.f / 128.f) + EPS);
      const long off = (tok0 + t) * 2048 + h * 128 + part * 16;
      const unsigned gu[8] = {g0.x, g0.y, g0.z, g0.w, g1.x, g1.y, g1.z, g1.w};
      unsigned ru[8];
      _Pragma("unroll") for (int i = 0; i < 8; ++i) { const float w0 = hgw[2 * i], w1 = hgw[2 * i + 1];
        ru[i] = pk2(ov[2 * i] * rs * w0 * lo_f(gu[i]), ov[2 * i + 1] * rs * w1 * hi_f(gu[i])); }
      *(uint4*)(oa + off) = uint4{ru[0], ru[1], ru[2], ru[3]}; *(uint4*)(oa + off + 8) = uint4{ru[4], ru[5], ru[6], ru[7]};
    }
  }
}

struct JobD { unsigned long long a_off, b_off, o_off; int lda, K, nM, nN, mode, ldc; };
__constant__ JobD g_jobs[12] = {
    {OFF_H, OFF_FFN, R_ACT, 2048, 2048, 64, 44, M_SWIGLU, DFF},
    {R_ACT, OFF_FFN + SZ_FFN_GU, R_Y, DFF, DFF, 64, 8, M_STORE, 2048},
    {OFF_H, OFF_WIN, R_QS, 2048, 2048, 64, 37, M_WIN, 2048},
    {OFF_OA, OFF_XWKV, OFF_XAK, 2048, 2048, 8, 4, M_XAKV, 512},
    {OFF_CQ, OFF_WQUP, R_QF, 512, 512, 64, 12, M_STORE, 3072},
    {OFF_CKV, OFF_WKVUP, R_KN, 512, 512, 64, 16, M_KVUP, 2048},
    {OFF_H, OFF_WIN + 37ull * 256 * 2048 * 2, R_GATES, 2048, 2048, 64, 16, M_SIGMOID, 4096},
    {OFF_OA, OFF_WBRA, R_YM, 2048, 2048, 64, 8, M_BRA, 2048},
    {OFF_FFN, OFF_WBRB, R_YM, 2048, 2048, 64, 8, M_BRB, 2048},
    {R_YM, OFF_WOUT, R_Z, 2048, 2048, 64, 8, M_STORE, 2048},
    {OFF_H, OFF_XWQ, R_QXA, 2048, 2048, 64, 2, M_STORE, 512},
    {R_OXA, OFF_XWO, R_Z, 512, 512, 64, 8, M_STORE, 2048},
};
__constant__ int g_phase_jobs[19][3] = {
  {-1,-1,0}, {0,-1,0}, {1,-1,0}, {-1,-1,0}, {2,3,0}, {-1,-1,0}, {4,5,0}, {-1,-1,0}, {6,-1,0}, {7,8,1}, {9,-1,0},
  {-1,-1,0}, {10,-1,0}, {-1,-1,0}, {11,-1,0}, {-1,-1,0}, {0,-1,0}, {1,-1,0}, {-1,-1,0} };
#define WSB(off) ((bf16_t*)(ws + (off)))
DI void gemm_phase(const int wave_s, const int blk, const int nblk, unsigned char* ws, int ph, const bool skip_epi) {
  extern __shared__ __attribute__((aligned(16))) unsigned char smem[];
  bf16_t* shm = (bf16_t*)smem;
  const int ja = g_phase_jobs[ph][0], jb = g_phase_jobs[ph][1]; const bool pair = g_phase_jobs[ph][2] != 0;
  const int n0 = g_jobs[ja].nM * g_jobs[ja].nN;
  const int n1 = (jb >= 0 && !pair) ? g_jobs[jb].nM * g_jobs[jb].nN : 0;
  const int total = n0 + n1, nsub = pair ? 2 : 1;
  if (total >= 4 * nblk && (blk & 8)) { for (int i = 0; i < SKEW_ITERS; ++i) __builtin_amdgcn_s_sleep(127); }
  for (int L = blk; L < total; L += nblk) for (int sub = 0; sub < nsub; ++sub) {
    const bool second = pair ? (sub == 1) : (L >= n0);
    const JobD& D = g_jobs[second ? jb : ja];
    GemmJob J; J.A = WSB(D.a_off); J.Bt = WSB(D.b_off); J.o0 = WSB(D.o_off); J.lda = D.lda; J.K = D.K; J.nM = D.nM; J.nN = D.nN; J.mode = D.mode; J.ldc = D.ldc;
    const int l = (pair || !second) ? L : L - n0;
    int pm, pn; tile_map(l, J.nM, J.nN, pm, pn);
    const int txl = wave_s * 64 + lane_id_v();
    gemm_tile(txl, wave_s, shm, ws, J, pm, pn, skip_epi);
  }
}
DI void hgrn_phase(const int tx, const int blk, const int nblk, unsigned char* ws, const float* hgg) {
  extern __shared__ __attribute__((aligned(16))) unsigned char smem[];
  for (int u = blk; u < 128; u += nblk) hgrn_unit(tx, smem, WSB(R_QS), WSB(R_KK), WSB(R_IT), WSB(R_SOG), hgg, WSB(OFF_OA), u >> 4, u & 15);
}
DI void mla_attn_phase(const int tx, const int blk, const int nblk, unsigned char* ws) {
  extern __shared__ __attribute__((aligned(16))) unsigned char smem[];
  AttnArgs a; a.Q = WSB(R_QF); a.ldq = 3072; a.Kn = WSB(R_KN); a.ldk = 2048; a.Kpe = WSB(OFF_KPE); a.VT = WSB(R_VT); a.O = WSB(OFF_FFN); a.ldo = 2048;
  a.cosT = (const float*)(ws + OFF_COS); a.sinT = (const float*)(ws + OFF_SIN); a.H = 16; a.Sq = 2048; a.Sk = 2048; a.c = 0.07216878364870322f * 1.4426950408889634f;
  const bool xmap = (nblk == 256);
  for (int it = blk, s_ = 0; it < 1024; it += nblk, ++s_) {
    int bh = it & 127, qt;
    { const int j = it >> 7; qt = (0x54236710u >> (4 * j)) & 7; }
    if (xmap) { const int x = blk & 7, i = blk >> 3, g = i >> 3, p = i & 7, q = (p + 4) & 7;
      bh = s_ * 32 + g * 8 + x; qt = (s_ == 0) ? p : (s_ == 1) ? 7 - p : (s_ == 2) ? q : 7 - q; }
    const int txl = (tx & ~63) + lane_id_v();
    attn_unit<192, true>(txl, smem, a, bh >> 4, bh & 15, qt); }
}
DI void xa_attn_phase(const int tx, const int blk, const int nblk, unsigned char* ws) {
  extern __shared__ __attribute__((aligned(16))) unsigned char smem[];
  AttnArgs a; a.Q = WSB(R_QXA); a.ldq = 512; a.Kn = WSB(OFF_XAK); a.ldk = 512; a.Kpe = nullptr; a.VT = WSB(OFF_XAVT); a.O = WSB(R_OXA); a.ldo = 512;
  a.cosT = nullptr; a.sinT = nullptr; a.H = 4; a.Sq = 2048; a.Sk = 256; a.c = 0.08838834764831845f * 1.4426950408889634f;
  for (int it = blk; it < 256; it += nblk) { const int txl = (tx & ~63) + lane_id_v(); attn_unit<128, false>(txl, smem, a, it >> 5, (it >> 3) & 3, it & 7); }
}
DI void prologue_phase(const int tx, const int blk, const int nblk, const Params& p) {
  extern __shared__ __attribute__((aligned(16))) unsigned char smem[];
  unsigned char* ws = p.ws;
  float* lbp = (float*)(ws + OFF_LB); float* cosT = (float*)(ws + OFF_COS); float* sinT = (float*)(ws + OFF_SIN);
  const int tid = tx, gtid = blk * 512 + tid, gthreads = nblk * 512;
  float* tile = (float*)smem;
  if (tid < 33) ((const float**)(ws + OFF_TAB))[tid] = (tid < 32) ? p.in[tid] : (const float*)p.out;
  transpose_job(tid, tile, p.in[5], 2048, 5632, WSB(OFF_FFN), RM_GATE, blk, nblk);
  transpose_job(tid, tile, p.in[6], 2048, 5632, WSB(OFF_FFN), RM_UP, blk, nblk);
  transpose_job(tid, tile, p.in[7], 5632, 2048, WSB(OFF_FFN + SZ_FFN_GU), RM_ID, blk, nblk);
  transpose_job(tid, tile, p.in[10], 2048, 13376, WSB(OFF_WIN), RM_WIN, blk, nblk);
  transpose_job(tid, tile, p.in[13], 512, 3072, WSB(OFF_WQUP), RM_ID, blk, nblk);
  transpose_job(tid, tile, p.in[15], 512, 4096, WSB(OFF_WKVUP), RM_ID, blk, nblk);
  transpose_job(tid, tile, p.in[16], 2048, 2048, WSB(OFF_WBRA), RM_ID, blk, nblk);
  transpose_job(tid, tile, p.in[17], 2048, 2048, WSB(OFF_WBRB), RM_ID, blk, nblk);
  transpose_job(tid, tile, p.in[18], 2048, 2048, WSB(OFF_WOUT), RM_ID, blk, nblk);
  transpose_job(tid, tile, p.in[22], 2048, 512, WSB(OFF_XWQ), RM_ID, blk, nblk);
  transpose_job(tid, tile, p.in[23], 2048, 512, WSB(OFF_XWKV), RM_ID, blk, nblk);
  transpose_job(tid, tile, p.in[24], 2048, 512, WSB(OFF_XWKV) + 512 * 2048, RM_ID, blk, nblk);
  transpose_job(tid, tile, p.in[25], 512, 2048, WSB(OFF_XWO), RM_ID, blk, nblk);
  { uint4* z = (uint4*)(WSB(OFF_WIN) + 9280ull * 2048); const int n16 = 192 * 2048 * 2 / 16;
    const unsigned zv = (unsigned)tid >> 31;
    for (int i = gtid; i < n16; i += gthreads) z[i] = uint4{zv, zv, zv, zv}; }
  { const float* lg = p.in[3]; for (int i = gtid; i < 2048; i += gthreads) lbp[i] = 1.f / (1.f + fexp_(lg[2048 + i] - lg[i])); }
  { const int* pos = (const int*)p.in[2];
    for (int i = gtid; i < T_TOK * 32; i += gthreads) { const int row = i >> 5, f = i & 31;
      const float inv_freq = 1.0f / powf(10000.f, (float)(2 * f) / 64.f);
      const float ang = (float)pos[row] * inv_freq;
      const double rev = (double)ang * 0.15915494309189533577;
      const float fr_ = (float)(rev - rint(rev));
      cosT[i] = __builtin_amdgcn_cosf(fr_); sinT[i] = __builtin_amdgcn_sinf(fr_); } }
  norm_rows(tid, blk, nblk, T_TOK, p.in[0], nullptr, nullptr, 0.f, nullptr, p.in[4], WSB(OFF_H));
  norm_rows(tid, blk, nblk, 2048, p.in[1], nullptr, nullptr, 0.f, nullptr, p.in[21], WSB(OFF_OA));
}

__global__ void __launch_bounds__(512) mega(Params p) {
  extern __shared__ __attribute__((aligned(16))) unsigned char smem[];
  cg::grid_group grid = cg::this_grid();
  unsigned char* ws0 = p.ws;
#define TIN(i) (((const float* const*)(ws + OFF_TAB))[i])
#define TOUT ((float*)(((const float* const*)(ws + OFF_TAB))[32]))
  const int nblk0 = gridDim.x, blk0 = blockIdx.x;
  const int wave_s = __builtin_amdgcn_readfirstlane((int)(threadIdx.x >> 6));
  unsigned* bar_cnt = (unsigned*)(ws0 + OFF_BAR);
  if (blk0 == 0 && threadIdx.x == 0) __hip_atomic_store(bar_cnt + 8, 0u, __ATOMIC_RELAXED, __HIP_MEMORY_SCOPE_AGENT);
  grid.sync();
  const int last_ph = p.last_ph + p.nextra;
  const int ex0 = p.extra[0], ex1 = p.extra[1], ex2 = p.extra[2], ex3 = p.extra[3];
  for (int step = 0; step <= last_ph; ++step) {
    const int ph = step <= 18 ? step : (step == 19 ? ex0 : step == 20 ? ex1 : step == 21 ? ex2 : ex3);
    unsigned char* ws = ws0;
    int blk = blk0, nblk = nblk0;
    asm volatile("" : "+s"(ws), "+s"(blk), "+s"(nblk));
    const int tid = wave_s * 64 + lane_id_v();
    if (ph == 0) prologue_phase(tid, blk, nblk, p);
    else if (ph == 3) norm_rows(tid, blk, nblk, T_TOK, TIN(0), WSB(R_Y), TIN(8), 0.5f, TOUT, TIN(9), WSB(OFF_H));
    else if (ph == 5) {
      if (blk < 128) hgrn_phase(tid, blk, nblk, ws, TIN(11));
      const bool split = nblk > 128;
      if (!split || blk >= 128)
        mla_prep(tid, WSB(OFF_CQ), WSB(OFF_CKV), WSB(OFF_KPE), TIN(12), TIN(14), (const float*)(ws + OFF_COS), (const float*)(ws + OFF_SIN),
                 (split ? blk - 128 : blk) * 8 + (tid >> 6), (split ? nblk - 128 : nblk) * 8);
    } else if (ph == 7) mla_attn_phase(tid, blk, nblk, ws);
    else if (ph == 11) {
      norm_rows(tid, blk, nblk, T_TOK, TOUT, WSB(R_Z), TIN(19), 1.0f, TOUT, TIN(20), WSB(OFF_H));
      float* tile = (float*)smem;
      transpose_job(tid, tile, TIN(28), 2048, 5632, WSB(OFF_FFN), RM_GATE, blk, nblk);
      transpose_job(tid, tile, TIN(29), 2048, 5632, WSB(OFF_FFN), RM_UP, blk, nblk);
      transpose_job(tid, tile, TIN(30), 5632, 2048, WSB(OFF_FFN + SZ_FFN_GU), RM_ID, blk, nblk);
    } else if (ph == 13) xa_attn_phase(tid, blk, nblk, ws);
    else if (ph == 15) norm_rows(tid, blk, nblk, T_TOK, TOUT, WSB(R_Z), TIN(26), 1.0f, TOUT, TIN(27), WSB(OFF_H));
    else if (ph == 30) norm_rows(tid, blk, nblk, T_TOK, TOUT, WSB(R_Z), TIN(26), 1.0f, nullptr, TIN(27), WSB(OFF_H));
    else if (ph == 18) norm_rows(tid, blk, nblk, T_TOK, TOUT, WSB(R_Y), TIN(31), 0.5f, TOUT, nullptr, nullptr);
    else if (ph < 19) gemm_phase(wave_s, blk, nblk, ws, ph, false);
    if (step < last_ph) {
      asm volatile("s_waitcnt vmcnt(0) lgkmcnt(0)" ::: "memory");
      __syncthreads();
      if (wave_s == 0 && lane_id_v() == 0) {
        __builtin_amdgcn_fence(__ATOMIC_RELEASE, "agent");
        asm volatile("s_waitcnt vmcnt(0)" ::: "memory");
        const unsigned ng = (nblk % 16 == 0) ? 16u : 1u, gsz = (unsigned)nblk / ng, grp_ = (unsigned)blk % ng;
        const unsigned old_ = __hip_atomic_fetch_add(bar_cnt + 16 * (1 + grp_), 1u, __ATOMIC_RELAXED, __HIP_MEMORY_SCOPE_AGENT);
        if (old_ + 1u == (unsigned)(step + 1) * gsz) __hip_atomic_fetch_add(bar_cnt, 1u, __ATOMIC_RELAXED, __HIP_MEMORY_SCOPE_AGENT);
        const unsigned target = (unsigned)(step + 1) * ng;
        while (__hip_atomic_load(bar_cnt, __ATOMIC_RELAXED, __HIP_MEMORY_SCOPE_AGENT) < target) __builtin_amdgcn_s_sleep(1);
        __builtin_amdgcn_fence(__ATOMIC_ACQUIRE, "agent");
        asm volatile("s_waitcnt vmcnt(0)" ::: "memory");
      }
      __syncthreads();
    }
  }
#if DBG_DUMP
  {
    unsigned char* ws = ws0;
    __threadfence(); __syncthreads();
    if (wave_s == 0 && lane_id_v() == 0) {
      __hip_atomic_fetch_add(bar_cnt, 1u, __ATOMIC_RELEASE, __HIP_MEMORY_SCOPE_AGENT);
      const unsigned target = (unsigned)(last_ph + 1) * (unsigned)nblk0;
      while (__hip_atomic_load(bar_cnt, __ATOMIC_ACQUIRE, __HIP_MEMORY_SCOPE_AGENT) < target) __builtin_amdgcn_s_sleep(2);
    }
    __syncthreads(); __threadfence();
    const size_t offs[8] = DBG_OFFS; const size_t lens[8] = DBG_LENS;
    float* o = (float*)(((const float* const*)(ws + OFF_TAB))[32]);
    const int tid = wave_s * 64 + lane_id_v();
    for (long i = (long)blk0 * 512 + tid; i < (long)T_TOK * 2048; i += (long)nblk0 * 512) {
      float acc = 0.f;
      for (int k = 0; k < 8; ++k) if (lens[k]) { float v = bf2f(((const bf16_t*)(ws + offs[k]))[i % lens[k]]); { const int rr = (int)((i >> 11) & 2047), cc = (int)(i & 2047); v = (fabsf(v) > 1.001f) ? (rr < 2 ? 1000.f : (rr < 4 ? 3000.f : 9000.f)) : 0.f; } acc += v; }
      o[i] = acc;
    }
  }
#endif
}

extern "C" void kernel_launch(void* const* d_in, const int* in_sizes, int n_in,
                              void* d_out, int out_size, void* d_ws, size_t ws_size,
                              hipStream_t stream) {
  constexpr size_t kDynLds = 131072;
  static int grid_blocks = 0;
  if (!grid_blocks) {
    if (n_in != 32 || ws_size < WS_END) { fprintf(stderr, "kernel_launch: need 32 inputs and %zu ws bytes (got %d, %zu)\n", (size_t)WS_END, n_in, ws_size); grid_blocks = -1; return; }
    int dev = 0, cus = 0, per_cu = 0;
    (void)hipGetDevice(&dev);
    (void)hipDeviceGetAttribute(&cus, hipDeviceAttributeMultiprocessorCount, dev);
    (void)hipFuncSetAttribute((const void*)mega, hipFuncAttributeMaxDynamicSharedMemorySize, (int)kDynLds);
    (void)hipOccupancyMaxActiveBlocksPerMultiprocessor(&per_cu, (const void*)mega, 512, kDynLds);
    if (per_cu < 1) per_cu = 1;
    if (per_cu > 1) per_cu = 1;
    grid_blocks = cus * per_cu;
  }
  if (grid_blocks < 0) return;
  (void)hipMemsetAsync((unsigned char*)d_ws + OFF_BAR, 0, 2048, stream);
  Params p{};
  _Pragma("unroll") for (int i = 0; i < 32; ++i) p.in[i] = (const float*)d_in[i];
  p.out = (float*)d_out;
  p.ws = (unsigned char*)d_ws;
  p.last_ph = LAST_PH;
  { const int ex[4] = EXTRA_PH; p.nextra = N_EXTRA; for (int i = 0; i < 4; ++i) p.extra[i] = ex[i]; }
  void* args[] = {&p};
  hipError_t e = hipLaunchCooperativeKernel((const void*)mega, dim3(grid_blocks), dim3(512), args, kDynLds, stream);
  if (e != hipSuccess) fprintf(stderr, "coop launch failed: %s\n", hipGetErrorString(e));
}
```
